# Optimizing an MI355X kernel written in HIP

```python
import math
import jax
import jax.numpy as jnp
from jax import lax
import numpy as np

D_MODEL = 1024
BATCH = 32
SEQ = 256
DEPTH = 2
DEC_BATCH = 8
DEC_SEQ = 2048
PAST_LEN = 256

GRID_W = 64
EPS = 1e-6
MLA_HEADS = 8
Q_LORA = 384
KV_LORA = 256
QK_NOPE = 64
QK_ROPE = 32
V_HEAD = 64
MLA_W = MLA_HEADS * V_HEAD
ROPE_THETA = 10000.0
Q_BLOCK = 128
CONV_W = 512
CONV_K = 3
GDN_HEADS = 8
GDN_DK = 64
GDN_DV = 64
GDN_QK_W = GDN_HEADS * GDN_DK
GDN_V_W = GDN_HEADS * GDN_DV
GDN_CHUNK = 64
N_BRANCH = 3
IN_SIZES = (Q_LORA, KV_LORA, QK_ROPE, MLA_W,
            CONV_W, CONV_W, CONV_W, CONV_W,
            GDN_QK_W, GDN_QK_W, GDN_V_W, GDN_V_W,
            GDN_HEADS, GDN_HEADS, GDN_HEADS, GDN_HEADS,
            N_BRANCH * D_MODEL)
D_IN = sum(IN_SIZES)

kernel_name = 'hybrid_mla_conv_gdn_diffusion_step'


def rms_norm(x, g):
    xf = x.astype(jnp.float32)
    y = xf * lax.rsqrt(jnp.mean(xf * xf, axis=-1, keepdims=True) + EPS)
    return (y * g.astype(jnp.float32)).astype(x.dtype)


def l2_normalize(x):
    return x * lax.rsqrt(jnp.sum(x * x, axis=-1, keepdims=True) + EPS)


def split_columns(u):
    parts, start = [], 0
    for n in IN_SIZES:
        parts.append(u[..., start:start + n])
        start += n
    return parts


def axial_rope_tables(n_tokens):
    rows = n_tokens // GRID_W
    t = jnp.arange(rows * GRID_W)
    row = (t // GRID_W).astype(jnp.float32)
    col = (t % GRID_W).astype(jnp.float32)
    n_freq = QK_ROPE // 4
    inv_freq = ROPE_THETA ** (-jnp.arange(n_freq, dtype=jnp.float32) / n_freq)
    ang = jnp.concatenate([row[:, None] * inv_freq, col[:, None] * inv_freq], axis=-1)
    return jnp.cos(ang), jnp.sin(ang)


def apply_rope(x, cos, sin):
    xf = x.astype(jnp.float32).reshape(x.shape[:-1] + (QK_ROPE // 2, 2))
    x0, x1 = xf[..., 0], xf[..., 1]
    out = jnp.stack([x0 * cos - x1 * sin, x0 * sin + x1 * cos], axis=-1)
    return out.reshape(x.shape).astype(x.dtype)


def short_conv(x, w):
    s = x.shape[1]
    pad = CONV_K // 2
    xp = jnp.pad(x, ((0, 0), (pad, pad), (0, 0)))
    y = xp[:, 0:s] * w[0]
    for i in range(1, CONV_K):
        y = y + xp[:, i:i + s] * w[i]
    return y


def adaln_projection(x, cond, p):
    mod = jax.nn.silu(cond) @ p['w_ada'] + p['b_ada']
    shift, scale, gate = jnp.split(mod[:, None, :], 3, axis=-1)
    h = rms_norm(x, p['norm_g']) * (1.0 + scale) + shift
    return split_columns(h @ p['w_in']), gate


def mla_queries_and_latent(cq, ckv, p):
    b, s, _ = cq.shape
    q = (rms_norm(cq, p['q_norm_g']) @ p['w_uq']).reshape(b, s, MLA_HEADS, QK_NOPE + QK_ROPE)
    return q[..., :QK_NOPE], q[..., QK_NOPE:], rms_norm(ckv, p['kv_norm_g'])


def mla_expand(ckv_n, w_ukv):
    b, s, _ = ckv_n.shape
    kv = (ckv_n @ w_ukv).reshape(b, s, MLA_HEADS, QK_NOPE + V_HEAD)
    return kv[..., :QK_NOPE], kv[..., QK_NOPE:]


def mla_attention(q_nope, q_rope, k_nope, k_rope, v):
    b, sq, h, _ = q_nope.shape
    nb = sq // Q_BLOCK
    scale = (QK_NOPE + QK_ROPE) ** -0.5

    def to_blocks(a):
        return jnp.moveaxis(a.reshape((b, nb, Q_BLOCK) + a.shape[2:]), 1, 0)

    def block(qs):
        qn, qr = qs
        s = (jnp.einsum('bqhd,bkhd->bhqk', qn, k_nope)
             + jnp.einsum('bqhr,bkr->bhqk', qr, k_rope)).astype(jnp.float32) * scale
        pr = jax.nn.softmax(s, axis=-1).astype(v.dtype)
        return jnp.einsum('bhqk,bkhd->bqhd', pr, v)

    o = lax.map(block, (to_blocks(q_nope), to_blocks(q_rope)))
    return jnp.moveaxis(o, 0, 1).reshape(b, sq, h * V_HEAD)


def conv_branch(b_in, c_in, x_in, gate, w):
    return b_in * short_conv(c_in * x_in, w) * jax.nn.silu(gate)


def gated_delta_chunked(q, k, v, g, beta, h0):
    b, s, h, dk = q.shape
    dv = v.shape[-1]
    c = GDN_CHUNK
    n = s // c

    def chunks(a):
        a = a.reshape((b, n, c, h) + a.shape[3:])
        return jnp.moveaxis(jnp.moveaxis(a, 1, 0), 3, 2)

    qc, kc, vc, bc = chunks(q), chunks(k), chunks(v), chunks(beta)
    gc = jnp.cumsum(chunks(g), axis=-1)
    idx = jnp.arange(c)
    lower = idx[:, None] >= idx[None, :]
    strict = idx[:, None] > idx[None, :]
    decay = jnp.exp(jnp.where(lower, gc[..., :, None] - gc[..., None, :], -jnp.inf))
    kb = kc * bc[..., None]
    a_mat = jnp.where(strict, jnp.einsum('nbhik,nbhjk->nbhij', kb, kc) * decay, 0.0) + jnp.eye(c, dtype=jnp.float32)
    rhs = jnp.concatenate([vc * bc[..., None], kb * jnp.exp(gc)[..., None]], axis=-1)
    sol = lax.linalg.triangular_solve(a_mat, rhs, left_side=True, lower=True, unit_diagonal=True)
    u, w = sol[..., :dv], sol[..., dv:]
    attn = jnp.where(lower, jnp.einsum('nbhik,nbhjk->nbhij', qc, kc) * decay, 0.0)
    q_dec = qc * jnp.exp(gc)[..., None]
    g_last = gc[..., -1]
    k_dec = kc * jnp.exp(g_last[..., None] - gc)[..., None]

    def step(state, xs):
        u_i, w_i, qd_i, kd_i, at_i, gl_i = xs
        v_new = u_i - jnp.einsum('bhck,bhkv->bhcv', w_i, state)
        o_i = jnp.einsum('bhck,bhkv->bhcv', qd_i, state) + jnp.einsum('bhij,bhjv->bhiv', at_i, v_new)
        state = state * jnp.exp(gl_i)[..., None, None] + jnp.einsum('bhck,bhcv->bhkv', kd_i, v_new)
        return state, o_i

    h_fin, o = lax.scan(step, h0, (u, w, q_dec, k_dec, attn, g_last))
    o = jnp.swapaxes(jnp.moveaxis(o, 0, 1), 2, 3).reshape(b, s, h, dv)
    return o, h_fin


def gdn_branch(q_in, k_in, v_in, z, a_f, a_b, b_f, b_b, h0, p):
    b, s, _ = q_in.shape
    f32 = jnp.float32
    qkv = jax.nn.silu(short_conv(jnp.concatenate([q_in, k_in, v_in], axis=-1), p['conv_qkv_w'])).astype(f32)
    q = l2_normalize(qkv[..., :GDN_QK_W].reshape(b, s, GDN_HEADS, GDN_DK)) * (GDN_DK ** -0.5)
    k = l2_normalize(qkv[..., GDN_QK_W:2 * GDN_QK_W].reshape(b, s, GDN_HEADS, GDN_DK))
    v = qkv[..., 2 * GDN_QK_W:].reshape(b, s, GDN_HEADS, GDN_DV)
    a_log = p['a_log'].astype(f32)
    dt_bias = p['dt_bias'].astype(f32)
    g_f = -jnp.exp(a_log[0]) * jax.nn.softplus(a_f.astype(f32) + dt_bias[0])
    g_b = -jnp.exp(a_log[1]) * jax.nn.softplus(a_b.astype(f32) + dt_bias[1])
    beta_f = jax.nn.sigmoid(b_f.astype(f32))
    beta_b = jax.nn.sigmoid(b_b.astype(f32))
    h0 = h0.astype(f32)
    o_f, h_f = gated_delta_chunked(q, k, v, g_f, beta_f, h0[:, 0])
    rev = lambda a: jnp.flip(a, axis=1)
    o_r, h_r = gated_delta_chunked(rev(q), rev(k), rev(v), rev(g_b), rev(beta_b), h0[:, 1])
    o = rms_norm(o_f + rev(o_r), p['gdn_norm_g']).reshape(b, s, GDN_V_W).astype(z.dtype) * jax.nn.silu(z)
    return o, jnp.stack([h_f, h_r], axis=1)


def merge_branches(o_a, o_b, o_c, merge_g, p):
    s_a, s_b, s_c = jnp.split(jax.nn.sigmoid(merge_g), N_BRANCH, axis=-1)
    m = s_a * (o_a @ p['w_pa']) + s_b * (o_b @ p['w_pb']) + s_c * (o_c @ p['w_pc'])
    return m @ p['w_o']


def context_layer(x, cond, p):
    b, s, _ = x.shape
    parts, res_gate = adaln_projection(x, cond, p)
    cq, ckv, kpe, gate_a, b_in, c_in, x_in, gate_b, q_in, k_in, v_in, z, a_f, a_b, b_f, b_b, merge_g = parts
    q_nope, q_rope, ckv_n = mla_queries_and_latent(cq, ckv, p)
    k_nope, v = mla_expand(ckv_n, p['w_ukv'])
    o_a = mla_attention(q_nope, q_rope, k_nope, kpe, v) * jax.nn.silu(gate_a)
    o_b = conv_branch(b_in, c_in, x_in, gate_b, p['conv_b_w'])
    h0 = jnp.zeros((b, 2, GDN_HEADS, GDN_DK, GDN_DV), jnp.float32)
    o_c, h_fin = gdn_branch(q_in, k_in, v_in, z, a_f, a_b, b_f, b_b, h0, p)
    x = x + res_gate * merge_branches(o_a, o_b, o_c, merge_g, p)
    return x, ckv_n, kpe, h_fin.astype(x.dtype)


def latent_layer(x, cond, ckv_ctx, kpe_ctx, h_ctx, cos, sin, p):
    parts, res_gate = adaln_projection(x, cond, p)
    cq, ckv, kpe, gate_a, b_in, c_in, x_in, gate_b, q_in, k_in, v_in, z, a_f, a_b, b_f, b_b, merge_g = parts
    q_nope, q_rope, ckv_n = mla_queries_and_latent(cq, ckv, p)
    q_rope = apply_rope(q_rope, cos[:, None, :], sin[:, None, :])
    kpe = apply_rope(kpe, cos, sin)
    k_nope_l, v_l = mla_expand(ckv_n, p['w_ukv'])
    k_nope_c, v_c = mla_expand(ckv_ctx.astype(x.dtype), p['w_ukv'])
    k_nope = jnp.concatenate([k_nope_c, k_nope_l], axis=1)
    k_rope = jnp.concatenate([kpe_ctx.astype(x.dtype), kpe], axis=1)
    v = jnp.concatenate([v_c, v_l], axis=1)
    o_a = mla_attention(q_nope, q_rope, k_nope, k_rope, v) * jax.nn.silu(gate_a)
    o_b = conv_branch(b_in, c_in, x_in, gate_b, p['conv_b_w'])
    o_c, _ = gdn_branch(q_in, k_in, v_in, z, a_f, a_b, b_f, b_b, h_ctx, p)
    return x + res_gate * merge_branches(o_a, o_b, o_c, merge_g, p)


def setup_inputs(seed: int = 0) -> dict:
    key = jax.random.key(seed)
    ks = jax.random.split(key, 32)
    f32 = jnp.float32
    D = D_MODEL

    def nrm(k, shape, scale):
        return jax.random.normal(k, shape, f32) * scale

    a_vals = jax.random.uniform(ks[17], (DEPTH, 2, GDN_HEADS), f32, 1.0, 16.0)
    dt = jnp.exp(jax.random.uniform(ks[18], (DEPTH, 2, GDN_HEADS), f32, math.log(1e-3), math.log(1e-1)))
    return {
        'x_prompt': nrm(ks[0], (BATCH, SEQ, D), 1.0),
        'x_sample': nrm(ks[1], (DEC_BATCH, DEC_SEQ, D), 1.0),
        'c': nrm(ks[2], (DEC_BATCH, D), 1.0),
        'cache_ckv': nrm(ks[3], (DEC_BATCH, DEPTH, PAST_LEN, KV_LORA), 1.0),
        'cache_kpe': nrm(ks[4], (DEC_BATCH, DEPTH, PAST_LEN, QK_ROPE), 1.0),
        'state_gdn': nrm(ks[5], (DEC_BATCH, DEPTH, 2, GDN_HEADS, GDN_DK, GDN_DV), 0.1),
        'c_ctx': nrm(ks[6], (D,), 1.0),
        'norm_g': 1.0 + nrm(ks[7], (DEPTH, D), 0.02),
        'w_ada': nrm(ks[8], (DEPTH, D, 3 * D), 0.5 * D ** -0.5),
        'b_ada': nrm(ks[9], (DEPTH, 3 * D), 0.02),
        'w_in': nrm(ks[10], (DEPTH, D, D_IN), D ** -0.5),
        'q_norm_g': 1.0 + nrm(ks[11], (DEPTH, Q_LORA), 0.02),
        'kv_norm_g': 1.0 + nrm(ks[12], (DEPTH, KV_LORA), 0.02),
        'w_uq': nrm(ks[13], (DEPTH, Q_LORA, MLA_HEADS * (QK_NOPE + QK_ROPE)), Q_LORA ** -0.5),
        'w_ukv': nrm(ks[14], (DEPTH, KV_LORA, MLA_HEADS * (QK_NOPE + V_HEAD)), KV_LORA ** -0.5),
        'conv_b_w': nrm(ks[15], (DEPTH, CONV_K, CONV_W), CONV_K ** -0.5),
        'conv_qkv_w': nrm(ks[16], (DEPTH, CONV_K, 2 * GDN_QK_W + GDN_V_W), CONV_K ** -0.5),
        'a_log': jnp.log(a_vals),
        'dt_bias': dt + jnp.log(-jnp.expm1(-dt)),
        'gdn_norm_g': 1.0 + nrm(ks[19], (DEPTH, GDN_DV), 0.02),
        'w_pa': nrm(ks[20], (DEPTH, MLA_W, D), MLA_W ** -0.5),
        'w_pb': nrm(ks[21], (DEPTH, CONV_W, D), CONV_W ** -0.5),
        'w_pc': nrm(ks[22], (DEPTH, GDN_V_W, D), GDN_V_W ** -0.5),
        'w_o': nrm(ks[23], (DEPTH, D, D), D ** -0.5),
        'final_norm_g': 1.0 + nrm(ks[24], (D,), 0.02),
    }


def reference(x_prompt, x_sample, c, cache_ckv, cache_kpe, state_gdn, c_ctx, norm_g, w_ada, b_ada,
              w_in, q_norm_g, kv_norm_g, w_uq, w_ukv, conv_b_w, conv_qkv_w, a_log, dt_bias,
              gdn_norm_g, w_pa, w_pb, w_pc, w_o, final_norm_g):
    cond_ctx = jnp.broadcast_to(c_ctx[None, :], (x_prompt.shape[0], D_MODEL))
    cos, sin = axial_rope_tables(x_sample.shape[1])
    xp, xs = x_prompt, x_sample
    ckv_out, kpe_out, st_out = [], [], []
    for l in range(DEPTH):
        p = {'norm_g': norm_g[l], 'w_ada': w_ada[l], 'b_ada': b_ada[l], 'w_in': w_in[l],
             'q_norm_g': q_norm_g[l], 'kv_norm_g': kv_norm_g[l], 'w_uq': w_uq[l], 'w_ukv': w_ukv[l],
             'conv_b_w': conv_b_w[l], 'conv_qkv_w': conv_qkv_w[l], 'a_log': a_log[l],
             'dt_bias': dt_bias[l], 'gdn_norm_g': gdn_norm_g[l], 'w_pa': w_pa[l], 'w_pb': w_pb[l],
             'w_pc': w_pc[l], 'w_o': w_o[l]}
        xp, ckv_n, kpe, h_fin = context_layer(xp, cond_ctx, p)
        ckv_out.append(ckv_n)
        kpe_out.append(kpe)
        st_out.append(h_fin)
        xs = latent_layer(xs, c, cache_ckv[:, l], cache_kpe[:, l], state_gdn[:, l], cos, sin, p)
    y_prompt = rms_norm(xp, final_norm_g)
    y_sample = rms_norm(xs, final_norm_g)
    new_cache_ckv = jnp.stack(ckv_out, axis=1)
    new_cache_kpe = jnp.stack(kpe_out, axis=1)
    new_state_gdn = jnp.stack(st_out, axis=1)
    return (y_prompt, y_sample, new_cache_ckv, new_cache_kpe, new_state_gdn)
```

```cpp
#include <hip/hip_runtime.h>
#include <hip/hip_cooperative_groups.h>
#include <cstdio>
namespace cg = cooperative_groups;

typedef unsigned short u16;
typedef __attribute__((ext_vector_type(8))) short bf16x8;
typedef __attribute__((ext_vector_type(4))) short s16x4;
typedef __attribute__((ext_vector_type(16))) float f32x16;
typedef __attribute__((ext_vector_type(2))) __bf16 bf2_t;
typedef __attribute__((ext_vector_type(4))) unsigned u32x4;

#define DI __device__ __forceinline__
#define MFMA32(a, b, c) __builtin_amdgcn_mfma_f32_32x32x16_bf16((a), (b), (c), 0, 0, 0)

constexpr int D = 1024;
constexpr int DIN = 8384;
constexpr int UC = 5312;
constexpr int TG = 8192;
constexpr int KVROWS = 9216;
constexpr int C_CQ = 0, C_CKV = 384, C_KPE = 640, C_GA = 672, C_B = 1184, C_C = 1696, C_X = 2208, C_GB = 2720,
              C_Q = 3232, C_K = 3744, C_V = 4256, C_Z = 4768, C_AB = 5280, C_MG = 5312;
constexpr int LDS_MAIN = 73728;
constexpr int LDS_TOTAL = LDS_MAIN + 4096;
constexpr size_t OUT_CKV = 25165824, OUT_KPE = 29360128, OUT_ST = 29884416;

struct Params {
  const float *x_prompt, *x_sample, *c, *cache_ckv, *cache_kpe, *state_gdn, *c_ctx, *norm_g, *w_ada, *b_ada, *w_in,
      *q_norm_g, *kv_norm_g, *w_uq, *w_ukv, *conv_b_w, *conv_qkv_w, *a_log, *dt_bias, *gdn_norm_g, *w_pa, *w_pb, *w_pc,
      *w_o, *final_norm_g;
  float* out;
  char* ws;
};
constexpr size_t al256(size_t x) { return (x + 255) & ~(size_t)255; }
constexpr size_t O_WT1 = 0;
constexpr size_t O_WUQ = O_WT1 + al256((size_t)DIN * 1024 * 2);
constexpr size_t O_WUKVF = O_WUQ + al256((size_t)768 * 384 * 2);
constexpr size_t O_WUKV = O_WUKVF + al256((size_t)1024 * 256 * 2);
constexpr size_t O_WPA = O_WUKV + al256((size_t)1024 * 256 * 2);
constexpr size_t O_WPB = O_WPA + al256((size_t)1024 * 512 * 2);
constexpr size_t O_WPC = O_WPB + al256((size_t)1024 * 512 * 2);
constexpr size_t O_WO = O_WPC + al256((size_t)1024 * 512 * 2);
constexpr size_t O_MOD = O_WO + al256((size_t)1024 * 1024 * 2);
constexpr size_t O_H = O_MOD + al256((size_t)5 * 2 * 9 * 3072 * 4);
constexpr size_t O_U = O_H + al256((size_t)TG * 1024 * 2);
constexpr size_t O_GAB = O_U + al256((size_t)TG * UC * 2);
constexpr size_t O_Q = O_GAB + al256((size_t)TG * 32 * 4);
constexpr size_t O_KV = O_Q + al256((size_t)TG * 768 * 2);
constexpr size_t O_KR = O_KV + al256((size_t)KVROWS * 1024 * 2);
constexpr size_t O_CKVC = O_KR + al256((size_t)KVROWS * 32 * 2);
constexpr size_t O_GD = O_CKVC + al256((size_t)1024 * 256 * 2);
constexpr size_t O_OF = O_GD + al256((size_t)2 * 128 * 8 * 16384 * 2);
constexpr size_t O_OR = O_OF + al256((size_t)TG * 512 * 2);
constexpr size_t O_BAR = O_OR + al256((size_t)TG * 512 * 2);
constexpr size_t WS_NEED = O_BAR + 16384;
#define WSP(T, name, off) DI T* name(const Params& P) { return (T*)(P.ws + (off)); }
WSP(u16, pWT1, O_WT1) WSP(u16, pWUQ, O_WUQ) WSP(u16, pWUKVF, O_WUKVF) WSP(u16, pWUKV, O_WUKV) WSP(u16, pWPA, O_WPA)
WSP(u16, pWPB, O_WPB) WSP(u16, pWPC, O_WPC) WSP(u16, pWO, O_WO) WSP(float, pMOD, O_MOD) WSP(u16, pH, O_H) WSP(u16, pU, O_U)
WSP(float, pGAB, O_GAB) WSP(u16, pQ, O_Q) WSP(u16, pKV, O_KV) WSP(u16, pKR, O_KR) WSP(u16, pCKVC, O_CKVC) WSP(u16, pGD, O_GD)
WSP(u16, pOF, O_OF) WSP(u16, pOR, O_OR) WSP(float, pMF, O_GD)

struct Grp { int tok0, nseq, seqlen, latent, seq0, nchunk, kvlen; };
DI Grp make_grp(int g) {
  Grp r;
  if (g == 0) { r.tok0 = 0; r.nseq = 32; r.seqlen = 256; r.latent = 0; r.seq0 = 0; r.kvlen = 256; }
  else { r.tok0 = 8192 * g; r.nseq = 4; r.seqlen = 2048; r.latent = 1; r.seq0 = (g - 1) * 4; r.kvlen = 2304; }
  r.nchunk = r.seqlen / 64;
  return r;
}

DI int otid() { int t = __builtin_amdgcn_workitem_id_x(); asm volatile("" : "+v"(t)); return t; }
DI unsigned pk2(float a, float b) { bf2_t v; v[0] = (__bf16)a; v[1] = (__bf16)b; return __builtin_bit_cast(unsigned, v); }
DI u16 f2bf(float a) { return __builtin_bit_cast(u16, (__bf16)a); }
DI float bf2f(u16 x) { return __uint_as_float(((unsigned)x) << 16); }
DI float bflo(unsigned w) { return __uint_as_float(w << 16); }
DI float bfhi(unsigned w) { return __uint_as_float(w & 0xffff0000u); }
DI void unpack8(uint4 w, float* v) {
  v[0] = bflo(w.x); v[1] = bfhi(w.x); v[2] = bflo(w.y); v[3] = bfhi(w.y);
  v[4] = bflo(w.z); v[5] = bfhi(w.z); v[6] = bflo(w.w); v[7] = bfhi(w.w);
}
DI uint4 pack8(const float* v) { return make_uint4(pk2(v[0], v[1]), pk2(v[2], v[3]), pk2(v[4], v[5]), pk2(v[6], v[7])); }
DI float silu_f(float x) { return x / (1.f + __expf(-x)); }
DI float sigmoid_f(float x) { return 1.f / (1.f + __expf(-x)); }
DI int crow(int i, int h) { return (i & 3) + 8 * (i >> 2) + 4 * h; }
DI int swap23(int k) { return (k & ~12) | ((k & 4) << 1) | ((k & 8) >> 1); }
DI float wave_sum(float v) {
  v += __shfl_xor(v, 32); v += __shfl_xor(v, 16); v += __shfl_xor(v, 8);
  v += __shfl_xor(v, 4); v += __shfl_xor(v, 2); v += __shfl_xor(v, 1);
  return v;
}
DI bf16x8 pack_frag(const f32x16& x, int s) {
  uint4 p = make_uint4(pk2(x[8 * s], x[8 * s + 1]), pk2(x[8 * s + 2], x[8 * s + 3]), pk2(x[8 * s + 4], x[8 * s + 5]),
                       pk2(x[8 * s + 6], x[8 * s + 7]));
  return __builtin_bit_cast(bf16x8, p);
}
DI f32x16 zero16() { f32x16 z; for (int i = 0; i < 16; ++i) z[i] = 0.f; return z; }
DI void rope8(float* v, int pi0, int tpos) {
#pragma unroll
  for (int j = 0; j < 4; ++j) {
    int pi = pi0 + j;
    int f = pi & 7;
    float pos = (float)((pi < 8) ? (tpos >> 6) : (tpos & 63));
    float ang = pos * __builtin_amdgcn_exp2f(-(float)f * 1.6609640474436813f);
    float cs = __cosf(ang), sn = __sinf(ang);
    float x0 = v[2 * j], x1 = v[2 * j + 1];
    v[2 * j] = x0 * cs - x1 * sn;
    v[2 * j + 1] = x0 * sn + x1 * cs;
  }
}

DI void mod_item(const Params& P, int it, float* lds) {
  const int kq4 = it & 3, cg = (it >> 2) % 48, l = it / 192;
  const int c0 = cg * 64;
  int tid = otid();
  float* sc = lds;
  for (int i = tid; i < 9 * 256; i += 256) {
    int b = i >> 8, k = kq4 * 256 + (i & 255);
    float cv = (b == 0) ? P.c_ctx[k] : P.c[(b - 1) * 1024 + k];
    sc[i] = silu_f(cv);
  }
  __syncthreads();
  int col = tid & 63, kq = tid >> 6;
  float acc[9];
#pragma unroll
  for (int b = 0; b < 9; ++b) acc[b] = 0.f;
  const float* w = P.w_ada + (size_t)l * 1024 * 3072 + (size_t)(kq4 * 256 + kq * 64) * 3072 + c0 + col;
#pragma unroll 8
  for (int k = 0; k < 64; ++k) {
    float wv = w[(size_t)k * 3072];
#pragma unroll
    for (int b = 0; b < 9; ++b) acc[b] += sc[b * 256 + kq * 64 + k] * wv;
  }
  float* red = lds + 9 * 256;
#pragma unroll
  for (int b = 0; b < 9; ++b) red[(kq * 9 + b) * 64 + col] = acc[b];
  __syncthreads();
  for (int i = tid; i < 9 * 64; i += 256) {
    int b = i >> 6, cc = i & 63;
    float s = red[(0 * 9 + b) * 64 + cc] + red[(1 * 9 + b) * 64 + cc] + red[(2 * 9 + b) * 64 + cc] + red[(3 * 9 + b) * 64 + cc];
    if (kq4 == 0) s += P.b_ada[l * 3072 + c0 + cc];
    pMOD(P)[(size_t)kq4 * 55296 + (l * 9 + b) * 3072 + c0 + cc] = s;
  }
  __syncthreads();
}
DI float4 mod4(const float* p) {
  float4 a = *(const float4*)p, b = *(const float4*)(p + 55296), c = *(const float4*)(p + 2 * 55296), d = *(const float4*)(p + 3 * 55296);
  return make_float4(a.x + b.x + c.x + d.x, a.y + b.y + c.y + d.y, a.z + b.z + c.z + d.z, a.w + b.w + c.w + d.w);
}

DI void convT_tile(const float* __restrict__ src, int K, int N, u16* __restrict__ dst, const float* __restrict__ g, int tk, int tn, float* lds) {
  int tid = otid();
  int k0 = tk * 64, n0 = tn * 64;
  for (int i = tid; i < 4096; i += 256) {
    int kk = i >> 6, nn = i & 63;
    float v = src[(size_t)(k0 + kk) * N + n0 + nn];
    if (g) v *= g[k0 + kk];
    lds[kk * 65 + nn] = v;
  }
  __syncthreads();
  for (int i = tid; i < 512; i += 256) {
    int nn = i >> 3, kc = (i & 7) * 8;
    float v[8];
#pragma unroll
    for (int j = 0; j < 8; ++j) v[j] = lds[(kc + j) * 65 + nn];
    *(uint4*)&dst[(size_t)(n0 + nn) * K + k0 + kc] = pack8(v);
  }
  __syncthreads();
}

DI void convert_phase(const Params& P, int l, float* lds) {
  for (int it = blockIdx.x; it < 2936; it += gridDim.x) {
    int i = it;
    if (i < 2096) { convT_tile(P.w_in + (size_t)l * 1024 * DIN, 1024, DIN, pWT1(P), nullptr, i % 16, i / 16, lds); continue; }
    i -= 2096;
    if (i < 72) { convT_tile(P.w_uq + (size_t)l * 384 * 768, 384, 768, pWUQ(P), P.q_norm_g + l * 384, i % 6, i / 6, lds); continue; }
    i -= 72;
    if (i < 64) { convT_tile(P.w_ukv + (size_t)l * 256 * 1024, 256, 1024, pWUKVF(P), P.kv_norm_g + l * 256, i % 4, i / 4, lds); continue; }
    i -= 64;
    if (i < 64) { convT_tile(P.w_ukv + (size_t)l * 256 * 1024, 256, 1024, pWUKV(P), nullptr, i % 4, i / 4, lds); continue; }
    i -= 64;
    if (i < 128) { convT_tile(P.w_pa + (size_t)l * 512 * 1024, 512, 1024, pWPA(P), nullptr, i % 8, i / 8, lds); continue; }
    i -= 128;
    if (i < 128) { convT_tile(P.w_pb + (size_t)l * 512 * 1024, 512, 1024, pWPB(P), nullptr, i % 8, i / 8, lds); continue; }
    i -= 128;
    if (i < 128) { convT_tile(P.w_pc + (size_t)l * 512 * 1024, 512, 1024, pWPC(P), nullptr, i % 8, i / 8, lds); continue; }
    i -= 128;
    convT_tile(P.w_o + (size_t)l * 1024 * 1024, 1024, 1024, pWO(P), nullptr, i % 16, i / 16, lds);
  }
}

DI const float* x_row(const Params& P, int l, int tok) {
  if (l == 0) return (tok < 8192) ? P.x_prompt + (size_t)tok * 1024 : P.x_sample + (size_t)(tok - 8192) * 1024;
  return P.out + (size_t)tok * 1024;
}
DI void norm_phase(const Params& P, const Grp& G, int l, bool first = false) {
  int wave = (blockIdx.x * 256 + otid()) >> 6, lane = otid() & 63, nw = gridDim.x * 4;
  const float* ng = P.norm_g + l * 1024;
  for (int r = wave; r < TG; r += nw) {
    int tok = G.tok0 + r;
    const float* xr = x_row(P, l, tok);
    int cond = G.latent ? 1 + G.seq0 + (r >> 11) : 0;
    const float* mod = pMOD(P) + (l * 9 + cond) * 3072;
    float4 v[4];
    float ss = 0.f;
#pragma unroll
    for (int i = 0; i < 4; ++i) {
      v[i] = *(const float4*)(xr + i * 256 + lane * 4);
      ss += v[i].x * v[i].x + v[i].y * v[i].y + v[i].z * v[i].z + v[i].w * v[i].w;
    }
    ss = wave_sum(ss);
    float rstd = rsqrtf(ss * (1.f / 1024.f) + 1e-6f);
#pragma unroll
    for (int i = 0; i < 4; ++i) {
      int col = i * 256 + lane * 4;
      float4 gg = *(const float4*)(ng + col);
      float4 sh = first ? mod4(mod + col) : *(const float4*)(mod + 4 * 55296 + col);
      float4 scl = first ? mod4(mod + 1024 + col) : *(const float4*)(mod + 4 * 55296 + 1024 + col);
      float h0 = v[i].x * rstd * gg.x * (1.f + scl.x) + sh.x;
      float h1 = v[i].y * rstd * gg.y * (1.f + scl.y) + sh.y;
      float h2 = v[i].z * rstd * gg.z * (1.f + scl.z) + sh.z;
      float h3 = v[i].w * rstd * gg.w * (1.f + scl.w) + sh.w;
      *(uint2*)&pH(P)[(size_t)r * 1024 + col] = make_uint2(pk2(h0, h1), pk2(h2, h3));
    }
  }
  if (G.latent) {
    int gt = blockIdx.x * 256 + otid(), nth = gridDim.x * 256;
    for (int i = gt; i < 1024 * 256; i += nth) {
      int row = i >> 8, cc = i & 255;
      int sl = row >> 8, p = row & 255;
      pCKVC(P)[i] = f2bf(P.cache_ckv[(((size_t)(G.seq0 + sl) * 2 + l) * 256 + p) * 256 + cc]);
    }
    for (int i = gt; i < 1024 * 32; i += nth) {
      int row = i >> 5, cc = i & 31;
      int sl = row >> 8, p = row & 255;
      pKR(P)[((size_t)sl * 2304 + p) * 32 + cc] = f2bf(P.cache_kpe[(((size_t)(G.seq0 + sl) * 2 + l) * 256 + p) * 32 + cc]);
    }
  }
}

DI void g_load(u32x4 (&ra)[4], u32x4 (&rb)[4], const u16* ga, const u16* gb, size_t sa32, size_t sb32, int kt) {
#pragma unroll
  for (int i = 0; i < 4; ++i) {
    ra[i] = *(const u32x4*)(ga + i * sa32 + kt * 64);
    rb[i] = *(const u32x4*)(gb + i * sb32 + kt * 64);
  }
}
DI void l_store(const u32x4 (&ra)[4], const u32x4 (&rb)[4], u16* dA, u16* dB, int lrow, int lcol) {
#pragma unroll
  for (int i = 0; i < 4; ++i) {
    *(u32x4*)&dA[(lrow + 32 * i) * 72 + lcol] = ra[i];
    *(u32x4*)&dB[(lrow + 32 * i) * 72 + lcol] = rb[i];
  }
}
DI void t_compute(const u16* cA, const u16* cB, f32x16 (&acc)[2][2]) {
#pragma unroll
  for (int s = 0; s < 4; ++s) {
    bf16x8 a0 = *(const bf16x8*)(cA + s * 16);
    bf16x8 a1 = *(const bf16x8*)(cA + 32 * 72 + s * 16);
    bf16x8 b0 = *(const bf16x8*)(cB + s * 16);
    bf16x8 b1 = *(const bf16x8*)(cB + 32 * 72 + s * 16);
    acc[0][0] = MFMA32(b0, a0, acc[0][0]);
    acc[0][1] = MFMA32(b1, a0, acc[0][1]);
    acc[1][0] = MFMA32(b0, a1, acc[1][0]);
    acc[1][1] = MFMA32(b1, a1, acc[1][1]);
  }
}
DI void gemm_mainloop(const u16* __restrict__ A, int lda, const u16* __restrict__ B, int ldb, int K, u16* lds, f32x16 (&acc)[2][2]) {
  const int tid = otid(), lane = tid & 63, w = tid >> 6, wr = w >> 1, wc = w & 1, r = lane & 31, h = lane >> 5;
  u16* sA = lds;
  u16* sB = lds + 2 * 128 * 72;
  const int lrow = tid >> 3, lcol = (tid & 7) * 8;
  const u16* ga = A + (size_t)lrow * lda + lcol;
  const u16* gb = B + (size_t)swap23(lrow) * ldb + lcol;
  const size_t sa32 = (size_t)32 * lda, sb32 = (size_t)32 * ldb;
  u32x4 ra0[4], rb0[4], ra1[4], rb1[4];
  const int nk = K >> 6;
  const u16* cA = sA + (wr * 64 + r) * 72 + h * 8;
  const u16* cB = sB + (wc * 64 + r) * 72 + h * 8;
  g_load(ra0, rb0, ga, gb, sa32, sb32, 0);
  g_load(ra1, rb1, ga, gb, sa32, sb32, 1);
  l_store(ra0, rb0, sA, sB, lrow, lcol);
  __syncthreads();
  for (int kt = 0; kt < nk; kt += 2) {
    if (kt + 2 < nk) g_load(ra0, rb0, ga, gb, sa32, sb32, kt + 2);
    t_compute(cA, cB, acc);
    l_store(ra1, rb1, sA + 128 * 72, sB + 128 * 72, lrow, lcol);
    __syncthreads();
    if (kt + 3 < nk) g_load(ra1, rb1, ga, gb, sa32, sb32, kt + 3);
    t_compute(cA + 128 * 72, cB + 128 * 72, acc);
    if (kt + 2 < nk) l_store(ra0, rb0, sA, sB, lrow, lcol);
    __syncthreads();
  }
}

template <int UNR = 2, class F>
DI void gemm_epilogue(f32x16 (&acc)[2][2], float* cs, F f) {
  const int tid = otid(), lane = tid & 63, w = tid >> 6, wr = w >> 1, wc = w & 1, r = lane & 31, h = lane >> 5;
#pragma unroll
  for (int mt = 0; mt < 2; ++mt)
#pragma unroll
    for (int nt = 0; nt < 2; ++nt)
#pragma unroll
      for (int q = 0; q < 2; ++q) {
        float v[8];
#pragma unroll
        for (int j = 0; j < 8; ++j) v[j] = acc[mt][nt][8 * q + j];
        f(wr * 64 + mt * 32 + r, wc * 64 + nt * 32 + 16 * q + 8 * h, v);
      }
}

DI void stagger() { if (blockIdx.x >= (gridDim.x >> 1)) __builtin_amdgcn_s_sleep(24); }
DI void gemm1_tile(const Params& P, const Grp& G, int l, int mtile, int ntile, char* ldsraw) {
  u16* lds = (u16*)ldsraw;
  {
    const int m0 = mtile * 128, n0 = ntile * 128;
    f32x16 acc[2][2];
    acc[0][0] = zero16(); acc[0][1] = zero16(); acc[1][0] = zero16(); acc[1][1] = zero16();
    gemm_mainloop(pH(P) + (size_t)m0 * 1024, 1024, pWT1(P) + (size_t)n0 * 1024, 1024, 1024, lds, acc);
    gemm_epilogue(acc, (float*)ldsraw, [&](int row, int col, float* v) {
      int n = n0 + col;
      if (n >= UC) return;
      int lt = m0 + row;
      *(uint4*)&pU(P)[(size_t)lt * UC + n] = pack8(v);
      if (n >= C_KPE && n < C_KPE + 32) {
        int cc = n - C_KPE;
        int sl = lt / G.seqlen, tpos = lt % G.seqlen;
        if (!G.latent) {
          float* dst = P.out + OUT_KPE + (((size_t)sl * 2 + l) * 256 + tpos) * 32 + cc;
          *(float4*)dst = make_float4(v[0], v[1], v[2], v[3]);
          *(float4*)(dst + 4) = make_float4(v[4], v[5], v[6], v[7]);
          *(uint4*)&pKR(P)[(size_t)lt * 32 + cc] = pack8(v);
        } else {
          rope8(v, cc >> 1, tpos);
          *(uint4*)&pKR(P)[((size_t)sl * 2304 + 256 + tpos) * 32 + cc] = pack8(v);
        }
      } else if (n >= C_AB) {
        float* dst = pGAB(P) + (size_t)lt * 32 + (n - C_AB);
        *(float4*)dst = make_float4(v[0], v[1], v[2], v[3]);
        *(float4*)(dst + 4) = make_float4(v[4], v[5], v[6], v[7]);
      }
    });
  }
}
DI void gemm1_phase(const Params& P, const Grp& G, int l, char* ldsraw) {
  for (int it = blockIdx.x; it < 64 * 40; it += gridDim.x) {
    int xcd = it & 7, j = it >> 3;
    int sj = j / 40, q = j % 40;
    int S = xcd + 8 * sj;
    int mtile = (S & 7) * 8 + (q & 7), nidx = (S >> 3) * 5 + (q >> 3);
    gemm1_tile(P, G, l, mtile, nidx < 6 ? nidx : nidx + 2, ldsraw);
  }
}

DI void rowstat(const u16* __restrict__ A, int lda, int K, float* rs) {
  __syncthreads();
  int tid = otid();
  int row = tid >> 1, half = tid & 1;
  const u16* p = A + (size_t)row * lda + half * (K >> 1);
  float ss = 0.f;
  for (int c = 0; c < (K >> 4); ++c) {
    float v[8];
    unpack8(*(const uint4*)(p + c * 8), v);
#pragma unroll
    for (int j = 0; j < 8; ++j) ss += v[j] * v[j];
  }
  ss += __shfl_xor(ss, 1);
  if (half == 0) rs[row] = rsqrtf(ss / (float)K + 1e-6f);
  __syncthreads();
}

DI void qproj_tile(const Params& P, const Grp& G, int it, char* ldsraw) {
  u16* lds = (u16*)ldsraw;
  float* rs = (float*)(ldsraw + LDS_MAIN);
  int mtile = it / 6, ntile = it % 6;
  int m0 = mtile * 128, n0 = ntile * 128;
  const u16* A = pU(P) + (size_t)m0 * UC + C_CQ;
  rowstat(A, UC, 384, rs);
  f32x16 acc[2][2];
  acc[0][0] = zero16(); acc[0][1] = zero16(); acc[1][0] = zero16(); acc[1][1] = zero16();
  gemm_mainloop(A, UC, pWUQ(P) + (size_t)n0 * 384, 384, 384, lds, acc);
  gemm_epilogue(acc, (float*)ldsraw, [&](int row, int col, float* v) {
    int n = n0 + col, lt = m0 + row;
    float s = rs[row];
#pragma unroll
    for (int j = 0; j < 8; ++j) v[j] *= s;
    int d = n % 96;
    if (G.latent && d >= 64) rope8(v, (d - 64) >> 1, lt & 2047);
    *(uint4*)&pQ(P)[(size_t)lt * 768 + n] = pack8(v);
  });
}

DI void kvexp_tile(const Params& P, const Grp& G, int l, int it, char* ldsraw) {
  u16* lds = (u16*)ldsraw;
  float* rs = (float*)(ldsraw + LDS_MAIN);
  int mtile = it >> 3, ntile = it & 7;
  int n0 = ntile * 128;
  const bool cache = mtile >= 64;
  int m0 = (cache ? (mtile - 64) : mtile) * 128;
  const u16* A;
  int lda;
  const u16* W;
  if (!cache) {
    A = pU(P) + (size_t)m0 * UC + C_CKV; lda = UC; W = pWUKVF(P);
    rowstat(A, UC, 256, rs);
  } else {
    A = pCKVC(P) + (size_t)m0 * 256; lda = 256; W = pWUKV(P);
    __syncthreads();
    if (otid() < 128) rs[otid()] = 1.f;
    __syncthreads();
  }
  f32x16 acc[2][2];
  acc[0][0] = zero16(); acc[0][1] = zero16(); acc[1][0] = zero16(); acc[1][1] = zero16();
  gemm_mainloop(A, lda, W + (size_t)n0 * 256, 256, 256, lds, acc);
  gemm_epilogue(acc, (float*)ldsraw, [&](int row, int col, float* v) {
    int n = n0 + col, lr = m0 + row;
    float s = rs[row];
#pragma unroll
    for (int j = 0; j < 8; ++j) v[j] *= s;
    size_t kvrow;
    if (!G.latent) kvrow = lr;
    else if (!cache) kvrow = (size_t)(lr >> 11) * 2304 + 256 + (lr & 2047);
    else kvrow = (size_t)(lr >> 8) * 2304 + (lr & 255);
    *(uint4*)&pKV(P)[kvrow * 1024 + n] = pack8(v);
  });
  if (!G.latent && ntile == 0) {
    const float* kg = P.kv_norm_g + l * 256;
    for (int c = otid(); c < 128 * 32; c += 256) {
      int row = c >> 5, c8 = (c & 31) * 8;
      int lt = m0 + row;
      float v[8];
      unpack8(*(const uint4*)&pU(P)[(size_t)lt * UC + C_CKV + c8], v);
      float s = rs[row];
      float* dst = P.out + OUT_CKV + (((size_t)(lt >> 8) * 2 + l) * 256 + (lt & 255)) * 256 + c8;
      *(float4*)dst = make_float4(v[0] * s * kg[c8], v[1] * s * kg[c8 + 1], v[2] * s * kg[c8 + 2], v[3] * s * kg[c8 + 3]);
      *(float4*)(dst + 4) = make_float4(v[4] * s * kg[c8 + 4], v[5] * s * kg[c8 + 5], v[6] * s * kg[c8 + 6], v[7] * s * kg[c8 + 7]);
    }
    __syncthreads();
  }
}

DI f32x16 mm64_tile(const u16* A, const u16* Bt, int tm, int tn, int r, int h) {
  f32x16 acc = zero16();
  const u16* pa = A + (32 * tm + r) * 72 + 8 * h;
  const u16* pb = Bt + (32 * tn + r) * 72 + 8 * h;
#pragma unroll
  for (int s = 0; s < 4; ++s) acc = MFMA32(*(const bf16x8*)(pa + 16 * s), *(const bf16x8*)(pb + 16 * s), acc);
  return acc;
}

DI void gdn_prep_item(const Params& P, const Grp& G, int l, int it, char* ldsraw) {
  const int tid0 = otid();
  int t2 = it;
  const int N = G.nchunk;
  const int ctok = t2 % N; t2 /= N;
  const int head = t2 & 7, sl = t2 >> 3;
  u16* lds = (u16*)ldsraw;
  u16* Kn = lds;
  u16* Qn = lds + 4608;
  u16* VTb = lds + 9216;
  u16* KTb = lds + 13824;
  u16* KdT = lds + 18432;
  u16* AT = lds + 23040;
  float* Lf = (float*)(lds + 27648);
  float* sm = (float*)(ldsraw + LDS_MAIN);
  float* s_gc = sm; float* s_beta = sm + 64; float* s_eg = sm + 128; float* s_ekd = sm + 192;

  unsigned yp[3][8];
  {
    const int i = tid0 >> 2, part = tid0 & 3;
    const int tpos = ctok * 64 + i;
    const size_t lt = (size_t)sl * G.seqlen + tpos;
#pragma unroll
    for (int m = 0; m < 3; ++m) {
      const int cb = C_Q + m * 512 + head * 64 + part * 16;
      const float* cw = P.conv_qkv_w + (size_t)l * 3 * 1536 + m * 512 + head * 64 + part * 16;
      float y[16];
#pragma unroll
      for (int hf = 0; hf < 2; ++hf) {
        float xc[8], xm[8], xp[8];
        unpack8(*(const uint4*)&pU(P)[lt * UC + cb + hf * 8], xc);
        if (tpos > 0) unpack8(*(const uint4*)&pU(P)[(lt - 1) * UC + cb + hf * 8], xm);
        else { for (int j = 0; j < 8; ++j) xm[j] = 0.f; }
        if (tpos < G.seqlen - 1) unpack8(*(const uint4*)&pU(P)[(lt + 1) * UC + cb + hf * 8], xp);
        else { for (int j = 0; j < 8; ++j) xp[j] = 0.f; }
        float w0[8], w1[8], w2[8];
        *(float4*)&w0[0] = *(const float4*)(cw + hf * 8); *(float4*)&w0[4] = *(const float4*)(cw + hf * 8 + 4);
        *(float4*)&w1[0] = *(const float4*)(cw + 1536 + hf * 8); *(float4*)&w1[4] = *(const float4*)(cw + 1536 + hf * 8 + 4);
        *(float4*)&w2[0] = *(const float4*)(cw + 3072 + hf * 8); *(float4*)&w2[4] = *(const float4*)(cw + 3072 + hf * 8 + 4);
#pragma unroll
        for (int j = 0; j < 8; ++j) y[hf * 8 + j] = silu_f(xm[j] * w0[j] + xc[j] * w1[j] + xp[j] * w2[j]);
      }
      if (m < 2) {
        float sq = 0.f;
#pragma unroll
        for (int j = 0; j < 16; ++j) sq += y[j] * y[j];
        sq += __shfl_xor(sq, 1); sq += __shfl_xor(sq, 2);
        float iq = rsqrtf(sq + 1e-6f) * ((m == 0) ? 0.125f : 1.f);
#pragma unroll
        for (int j = 0; j < 16; ++j) y[j] *= iq;
      }
#pragma unroll
      for (int j = 0; j < 8; ++j) yp[m][j] = pk2(y[2 * j], y[2 * j + 1]);
    }
  }
  int ndir = 2;
  asm volatile("" : "+s"(ndir));
  for (int dir = 0; dir < ndir; ++dir) {
  const int tid = otid(), lane = tid & 63, w = tid >> 6, r = lane & 31, h = lane >> 5;
  const int i = tid >> 2, part = tid & 3;
  if (tid < 64) {
    const int ti = tid;
    const int tp = dir ? (ctok * 64 + 63 - ti) : (ctok * 64 + ti);
    const size_t ltg = (size_t)sl * G.seqlen + tp;
    float a = pGAB(P)[ltg * 32 + dir * 8 + head];
    float b = pGAB(P)[ltg * 32 + 16 + dir * 8 + head];
    float xs = a + P.dt_bias[l * 16 + dir * 8 + head];
    float sp = (xs > 20.f) ? xs : log1pf(__expf(xs));
    float g = -__expf(P.a_log[l * 16 + dir * 8 + head]) * sp;
#pragma unroll
    for (int off = 1; off < 64; off <<= 1) {
      float t = __shfl_up(g, off);
      if (ti >= off) g += t;
    }
    float gl = __shfl(g, 63);
    s_gc[ti] = g; s_beta[ti] = sigmoid_f(b); s_eg[ti] = __expf(g); s_ekd[ti] = __expf(gl - g);
  }
  __syncthreads();
  {
    const int ri = dir ? (63 - i) : i;
    const float be = s_beta[ri], eg = s_eg[ri], ekd = s_ekd[ri];
    *(uint4*)&Qn[ri * 72 + part * 16] = make_uint4(yp[0][0], yp[0][1], yp[0][2], yp[0][3]);
    *(uint4*)&Qn[ri * 72 + part * 16 + 8] = make_uint4(yp[0][4], yp[0][5], yp[0][6], yp[0][7]);
    *(uint4*)&Kn[ri * 72 + part * 16] = make_uint4(yp[1][0], yp[1][1], yp[1][2], yp[1][3]);
    *(uint4*)&Kn[ri * 72 + part * 16 + 8] = make_uint4(yp[1][4], yp[1][5], yp[1][6], yp[1][7]);
#pragma unroll
    for (int j = 0; j < 8; ++j) {
      const int cc = part * 16 + 2 * j;
      const float k0 = bflo(yp[1][j]), k1 = bfhi(yp[1][j]), v0 = bflo(yp[2][j]), v1 = bfhi(yp[2][j]);
      KTb[cc * 72 + ri] = f2bf(k0 * be * eg);  KTb[(cc + 1) * 72 + ri] = f2bf(k1 * be * eg);
      KdT[cc * 72 + ri] = f2bf(k0 * ekd);      KdT[(cc + 1) * 72 + ri] = f2bf(k1 * ekd);
      VTb[cc * 72 + ri] = f2bf(v0 * be);       VTb[(cc + 1) * 72 + ri] = f2bf(v1 * be);
    }
  }
  __syncthreads();
  const int tm = w >> 1, tn = w & 1;
  {
    f32x16 aK = mm64_tile(Kn, Kn, tm, tn, r, h);
    f32x16 aQ = mm64_tile(Qn, Kn, tm, tn, r, h);
    const int jj = 32 * tn + r;
    const float gcj = s_gc[jj];
#pragma unroll
    for (int ii = 0; ii < 16; ++ii) {
      const int ri = 32 * tm + crow(ii, h);
      float dec = (ri >= jj) ? __expf(s_gc[ri] - gcj) : 0.f;
      Lf[ri * 72 + jj] = (ri > jj) ? s_beta[ri] * aK[ii] * dec : 0.f;
      AT[ri * 72 + jj] = f2bf(aQ[ii] * dec);
    }
  }
  __syncthreads();
  float* Pf = (float*)Kn;
  if (w == 0) {
    const int b = lane >> 4, c = lane & 15;
    float t[16];
#pragma unroll
    for (int a = 0; a < 16; ++a) {
      float s = (a == c) ? 1.f : 0.f;
#pragma unroll
      for (int j = 0; j < a; ++j) s -= Lf[(16 * b + a) * 72 + 16 * b + j] * t[j];
      t[a] = s;
    }
#pragma unroll
    for (int a = 0; a < 16; ++a) Lf[(16 * b + a) * 72 + 16 * b + c] = t[a];
  }
  __syncthreads();
  for (int idx = tid; idx < 512; idx += 256) {
    const int p = idx >> 8, a = (idx >> 4) & 15, j = idx & 15;
    float s = 0.f;
#pragma unroll
    for (int k = 0; k < 16; ++k) s += Lf[(32 * p + 16 + a) * 72 + 32 * p + k] * Lf[(32 * p + k) * 72 + 32 * p + j];
    Pf[p * 256 + a * 16 + j] = s;
  }
  __syncthreads();
  for (int idx = tid; idx < 512; idx += 256) {
    const int p = idx >> 8, a = (idx >> 4) & 15, j = idx & 15;
    float s = 0.f;
#pragma unroll
    for (int k = 0; k < 16; ++k) s += Lf[(32 * p + 16 + a) * 72 + 32 * p + 16 + k] * Pf[p * 256 + k * 16 + j];
    Lf[(32 * p + 16 + a) * 72 + 32 * p + j] = -s;
  }
  __syncthreads();
  if (w == 0) {
    f32x16 acc = zero16();
#pragma unroll
    for (int s2 = 0; s2 < 16; ++s2)
      acc = __builtin_amdgcn_mfma_f32_32x32x2f32(Lf[(32 + r) * 72 + 2 * s2 + h], Lf[(2 * s2 + h) * 72 + r], acc, 0, 0, 0);
#pragma unroll
    for (int ii = 0; ii < 16; ++ii) Pf[crow(ii, h) * 32 + r] = acc[ii];
  }
  __syncthreads();
  if (w == 0) {
    f32x16 acc = zero16();
#pragma unroll
    for (int s2 = 0; s2 < 16; ++s2)
      acc = __builtin_amdgcn_mfma_f32_32x32x2f32(Lf[(32 + r) * 72 + 32 + 2 * s2 + h], Pf[(2 * s2 + h) * 32 + r], acc, 0, 0, 0);
#pragma unroll
    for (int ii = 0; ii < 16; ++ii) Lf[(32 + crow(ii, h)) * 72 + r] = -acc[ii];
  }
  __syncthreads();
  u16* Tb = Kn;
  for (int idx = tid; idx < 4096; idx += 256) {
    const int a = idx >> 6, j = idx & 63;
    Tb[a * 72 + j] = f2bf(Lf[a * 72 + j]);
  }
  __syncthreads();
  u16* UT = (u16*)Lf;
  u16* WT = UT + 4608;
  {
    f32x16 aU = mm64_tile(Tb, VTb, tm, tn, r, h);
    f32x16 aW = mm64_tile(Tb, KTb, tm, tn, r, h);
    __syncthreads();
#pragma unroll
    for (int g4 = 0; g4 < 4; ++g4) {
      const int ci = 32 * tm + 8 * g4 + 4 * h;
      *(uint2*)&UT[(32 * tn + r) * 72 + ci] = make_uint2(pk2(aU[4 * g4], aU[4 * g4 + 1]), pk2(aU[4 * g4 + 2], aU[4 * g4 + 3]));
      *(uint2*)&WT[(32 * tn + r) * 72 + ci] = make_uint2(pk2(aW[4 * g4], aW[4 * g4 + 1]), pk2(aW[4 * g4 + 2], aW[4 * g4 + 3]));
    }
  }
  __syncthreads();
  {
    const int cdir = dir ? (N - 1 - ctok) : ctok;
    u16* gd = pGD(P) + ((((size_t)dir * G.nseq + sl) * 8 + head) * N + cdir) * 16384;
    f32x16 a1 = mm64_tile(AT, WT, tm, tn, r, h);
    f32x16 a3 = mm64_tile(KdT, WT, tm, tn, r, h);
    const int cc = 32 * tn + r;
    const int pc = swap23(cc);
    const float egl = s_eg[63];
#pragma unroll
    for (int ii = 0; ii < 16; ++ii) {
      const int ri = 32 * tm + crow(ii, h);
      float qe = bf2f(Qn[ri * 72 + cc]) * s_eg[ri] - a1[ii];
      float mc = ((ri == cc) ? egl : 0.f) - a3[ii];
      gd[ri * 64 + pc] = f2bf(qe);
      gd[4096 + ri * 64 + pc] = f2bf(mc);
    }
    f32x16 a2 = mm64_tile(AT, UT, tm, tn, r, h);
    f32x16 a4 = mm64_tile(KdT, UT, tm, tn, r, h);
    u16* o3 = gd + 3 * 4096 + ((tm * 2 + tn) * 64 + lane) * 16;
    u16* o2 = gd + 2 * 4096 + ((tm * 2 + tn) * 64 + lane) * 16;
    *(uint4*)o3 = make_uint4(pk2(a2[0], a2[1]), pk2(a2[2], a2[3]), pk2(a2[4], a2[5]), pk2(a2[6], a2[7]));
    *(uint4*)(o3 + 8) = make_uint4(pk2(a2[8], a2[9]), pk2(a2[10], a2[11]), pk2(a2[12], a2[13]), pk2(a2[14], a2[15]));
    *(uint4*)o2 = make_uint4(pk2(a4[0], a4[1]), pk2(a4[2], a4[3]), pk2(a4[4], a4[5]), pk2(a4[6], a4[7]));
    *(uint4*)(o2 + 8) = make_uint4(pk2(a4[8], a4[9]), pk2(a4[10], a4[11]), pk2(a4[12], a4[13]), pk2(a4[14], a4[15]));
  }
  __syncthreads();
  }
}

DI f32x16 unpack16(const u16* p) {
  uint4 a = *(const uint4*)p, b = *(const uint4*)(p + 8);
  f32x16 v;
  v[0] = bflo(a.x); v[1] = bfhi(a.x); v[2] = bflo(a.y); v[3] = bfhi(a.y); v[4] = bflo(a.z); v[5] = bfhi(a.z); v[6] = bflo(a.w); v[7] = bfhi(a.w);
  v[8] = bflo(b.x); v[9] = bfhi(b.x); v[10] = bflo(b.y); v[11] = bfhi(b.y); v[12] = bflo(b.z); v[13] = bfhi(b.z); v[14] = bflo(b.w); v[15] = bfhi(b.w);
  return v;
}

struct ScanOps { bf16x8 qa[2][4], ma[2][4]; u32x4 bc[2][2], ou[2][2]; };
DI void scan_load(ScanOps& o, const u16* mb, int r, int h, int nt, int lane) {
#pragma unroll
  for (int mt = 0; mt < 2; ++mt) {
#pragma unroll
    for (int ks = 0; ks < 4; ++ks) {
      o.qa[mt][ks] = *(const bf16x8*)(mb + (32 * mt + r) * 64 + 16 * ks + 8 * h);
      o.ma[mt][ks] = *(const bf16x8*)(mb + 4096 + (32 * mt + r) * 64 + 16 * ks + 8 * h);
    }
    const u16* pb = mb + 2 * 4096 + ((mt * 2 + nt) * 64 + lane) * 16;
    const u16* po = mb + 3 * 4096 + ((mt * 2 + nt) * 64 + lane) * 16;
    o.bc[mt][0] = *(const u32x4*)pb; o.bc[mt][1] = *(const u32x4*)(pb + 8);
    o.ou[mt][0] = *(const u32x4*)po; o.ou[mt][1] = *(const u32x4*)(po + 8);
  }
}
DI f32x16 unpack16v(u32x4 a, u32x4 b) {
  f32x16 v;
  v[0] = bflo(a[0]); v[1] = bfhi(a[0]); v[2] = bflo(a[1]); v[3] = bfhi(a[1]); v[4] = bflo(a[2]); v[5] = bfhi(a[2]); v[6] = bflo(a[3]); v[7] = bfhi(a[3]);
  v[8] = bflo(b[0]); v[9] = bfhi(b[0]); v[10] = bflo(b[1]); v[11] = bfhi(b[1]); v[12] = bflo(b[2]); v[13] = bfhi(b[2]); v[14] = bflo(b[3]); v[15] = bfhi(b[3]);
  return v;
}
DI void scan_step(const ScanOps& o, f32x16 (&S)[2], u16* obuf, size_t rowbase, int ctok, int dir, int colbase, int h) {
  f32x16 ov[2], Sn[2];
#pragma unroll
  for (int mt = 0; mt < 2; ++mt) {
    Sn[mt] = unpack16v(o.bc[mt][0], o.bc[mt][1]);
    ov[mt] = unpack16v(o.ou[mt][0], o.ou[mt][1]);
  }
  bf16x8 Sb[4];
  Sb[0] = pack_frag(S[0], 0); Sb[1] = pack_frag(S[0], 1); Sb[2] = pack_frag(S[1], 0); Sb[3] = pack_frag(S[1], 1);
#pragma unroll
  for (int mt = 0; mt < 2; ++mt)
#pragma unroll
    for (int ks = 0; ks < 4; ++ks) {
      ov[mt] = MFMA32(o.qa[mt][ks], Sb[ks], ov[mt]);
      Sn[mt] = MFMA32(o.ma[mt][ks], Sb[ks], Sn[mt]);
    }
#pragma unroll
  for (int mt = 0; mt < 2; ++mt)
#pragma unroll
    for (int ii = 0; ii < 16; ++ii) {
      int ri = 32 * mt + crow(ii, h);
      int tpos = dir ? (ctok * 64 + 63 - ri) : (ctok * 64 + ri);
      obuf[(rowbase + tpos) * 512 + colbase] = f2bf(ov[mt][ii]);
    }
  S[0] = Sn[0]; S[1] = Sn[1];
}

DI void gdn_scan_item(const Params& P, const Grp& G, int l, int it) {
  const int tid = otid(), lane = tid & 63, w = tid >> 6, r = lane & 31, h = lane >> 5;
  const int head = it & 7, sl = it >> 3;
  const int dir = w >> 1, nt = w & 1;
  const int N = G.nchunk;
  f32x16 S[2];
  if (G.latent) {
    const float* st = P.state_gdn + ((((size_t)(G.seq0 + sl) * 2 + l) * 2 + dir) * 8 + head) * 4096;
#pragma unroll
    for (int mt = 0; mt < 2; ++mt)
#pragma unroll
      for (int ii = 0; ii < 16; ++ii) S[mt][ii] = st[(32 * mt + crow(ii, h)) * 64 + 32 * nt + r];
  } else { S[0] = zero16(); S[1] = zero16(); }
  const u16* base = pGD(P) + ((((size_t)dir * G.nseq + sl) * 8 + head) * N) * 16384;
  u16* obuf = dir ? pOR(P) : pOF(P);
  const size_t rowbase = (size_t)sl * G.seqlen;
  const int colbase = head * 64 + 32 * nt + r;
  ScanOps oa;
  for (int c = 0; c < N; ++c) {
    scan_load(oa, base + (size_t)c * 16384, r, h, nt, lane);
    scan_step(oa, S, obuf, rowbase, dir ? (N - 1 - c) : c, dir, colbase, h);
  }
  if (!G.latent) {
    float* st = P.out + OUT_ST + ((((size_t)sl * 2 + l) * 2 + dir) * 8 + head) * 4096;
#pragma unroll
    for (int mt = 0; mt < 2; ++mt)
#pragma unroll
      for (int ii = 0; ii < 16; ++ii) st[(32 * mt + crow(ii, h)) * 64 + 32 * nt + r] = S[mt][ii];
  }
  __threadfence();
  __syncthreads();
  __threadfence();
  const float* gn = P.gdn_norm_g + l * 64;
#pragma unroll 4
  for (int idx = tid; idx < G.seqlen * 8; idx += 256) {
    int tpos = idx >> 3, part = idx & 7;
    size_t lt = (size_t)sl * G.seqlen + tpos;
    float a[8], b[8], z[8];
    unpack8(*(const uint4*)&pOF(P)[lt * 512 + head * 64 + part * 8], a);
    unpack8(*(const uint4*)&pOR(P)[lt * 512 + head * 64 + part * 8], b);
    u16* zp = &pU(P)[lt * UC + C_Z + head * 64 + part * 8];
    unpack8(*(const uint4*)zp, z);
    float ss = 0.f;
#pragma unroll
    for (int j = 0; j < 8; ++j) { a[j] += b[j]; ss += a[j] * a[j]; }
    ss += __shfl_xor(ss, 1); ss += __shfl_xor(ss, 2); ss += __shfl_xor(ss, 4);
    float rstd = rsqrtf(ss * (1.f / 64.f) + 1e-6f);
#pragma unroll
    for (int j = 0; j < 8; ++j) a[j] = a[j] * rstd * gn[part * 8 + j] * silu_f(z[j]);
    *(uint4*)zp = pack8(a);
  }
  __syncthreads();
}

struct KvRegs { u32x4 k[2], kr, v[2]; };
DI void attn_gload(KvRegs& g, const u16* kvp, const u16* krp, size_t row0, int tid, int head) {
#pragma unroll
  for (int i2 = 0; i2 < 2; ++i2) {
    int c = tid + 256 * i2;
    int key = c >> 3, d8 = (c & 7) * 8;
    const u16* src = &kvp[(row0 + key) * 1024 + head * 128 + d8];
    g.k[i2] = *(const u32x4*)src;
    g.v[i2] = *(const u32x4*)(src + 64);
  }
  g.kr = *(const u32x4*)&krp[(row0 + (tid >> 2)) * 32 + (tid & 3) * 8];
}
DI void attn_lstore(const KvRegs& g, u16* Kl, u16* Vt, int tid) {
#pragma unroll
  for (int i2 = 0; i2 < 2; ++i2) {
    int c = tid + 256 * i2;
    int key = c >> 3, d8 = (c & 7) * 8;
    *(u32x4*)&Kl[key * 104 + d8] = g.k[i2];
    u32x4 vv = g.v[i2];
    u16* vd = &Vt[d8 * 72 + key];
    vd[0] = (u16)(vv[0] & 0xffff); vd[72] = (u16)(vv[0] >> 16); vd[144] = (u16)(vv[1] & 0xffff); vd[216] = (u16)(vv[1] >> 16);
    vd[288] = (u16)(vv[2] & 0xffff); vd[360] = (u16)(vv[2] >> 16); vd[432] = (u16)(vv[3] & 0xffff); vd[504] = (u16)(vv[3] >> 16);
  }
  *(u32x4*)&Kl[(tid >> 2) * 104 + 64 + (tid & 3) * 8] = g.kr;
}
DI void attn_tile(const u16* Kl, const u16* Vt, const bf16x8 (&qf)[6], f32x16 (&O)[2], float& mrun, float& lrun, int r, int h) {
  const float sc = 0.14724455f;
  f32x16 st[2];
#pragma unroll
  for (int mt = 0; mt < 2; ++mt) {
    st[mt] = zero16();
#pragma unroll
    for (int s = 0; s < 6; ++s) st[mt] = MFMA32(*(const bf16x8*)&Kl[(32 * mt + r) * 104 + 16 * s + 8 * h], qf[s], st[mt]);
  }
  float mloc = -1e30f;
#pragma unroll
  for (int mt = 0; mt < 2; ++mt)
#pragma unroll
    for (int ii = 0; ii < 16; ++ii) { st[mt][ii] *= sc; mloc = fmaxf(mloc, st[mt][ii]); }
  mloc = fmaxf(mloc, __shfl_xor(mloc, 32));
  const float mnew = fmaxf(mrun, mloc);
  const float alpha = __builtin_amdgcn_exp2f(mrun - mnew);
  mrun = mnew;
  float ps = 0.f;
#pragma unroll
  for (int mt = 0; mt < 2; ++mt)
#pragma unroll
    for (int ii = 0; ii < 16; ++ii) { float p = __builtin_amdgcn_exp2f(st[mt][ii] - mnew); st[mt][ii] = p; ps += p; }
  lrun = lrun * alpha + ps;
#pragma unroll
  for (int ii = 0; ii < 16; ++ii) { O[0][ii] *= alpha; O[1][ii] *= alpha; }
#pragma unroll
  for (int mt = 0; mt < 2; ++mt)
#pragma unroll
    for (int s2 = 0; s2 < 2; ++s2) {
      bf16x8 pb = pack_frag(st[mt], s2);
#pragma unroll
      for (int dvt = 0; dvt < 2; ++dvt) {
        const u16* vp = &Vt[(32 * dvt + r) * 72 + 32 * mt + 16 * s2 + 4 * h];
        s16x4 lo = *(const s16x4*)vp;
        s16x4 hi = *(const s16x4*)(vp + 8);
        bf16x8 va = __builtin_shufflevector(lo, hi, 0, 1, 2, 3, 4, 5, 6, 7);
        O[dvt] = MFMA32(va, pb, O[dvt]);
      }
    }
}

DI void attn_item(const Params& P, const Grp& G, int it, char* ldsraw) {
  const int tid = otid(), lane = tid & 63, w = tid >> 6, r = lane & 31, h = lane >> 5;
  const int nqb = G.seqlen >> 7;
  const int qb = it % nqb, head = (it / nqb) & 7, sl = it / (nqb * 8);
  u16* Kl0 = (u16*)ldsraw;
  u16* Vt0 = Kl0 + 64 * 104;
  u16* Kl1 = Vt0 + 64 * 72;
  u16* Vt1 = Kl1 + 64 * 104;
  const size_t ltq = (size_t)sl * G.seqlen + qb * 128 + w * 32 + r;
  bf16x8 qf[6];
#pragma unroll
  for (int s = 0; s < 6; ++s) qf[s] = *(const bf16x8*)&pQ(P)[ltq * 768 + head * 96 + s * 16 + h * 8];
  const int nkt = G.kvlen >> 6;
  const size_t kvbase = (size_t)sl * G.kvlen;
  const u16* kvp = pKV(P);
  const u16* krp = pKR(P);
  float mrun = -1e30f, lrun = 0.f;
  f32x16 O[2];
  O[0] = zero16(); O[1] = zero16();
  KvRegs g0, g1;
  attn_gload(g0, kvp, krp, kvbase, tid, head);
  attn_gload(g1, kvp, krp, kvbase + 64, tid, head);
  __syncthreads();
  attn_lstore(g0, Kl0, Vt0, tid);
  __syncthreads();
  for (int kt = 0; kt < nkt; kt += 2) {
    if (kt + 2 < nkt) attn_gload(g0, kvp, krp, kvbase + (size_t)(kt + 2) * 64, tid, head);
    attn_tile(Kl0, Vt0, qf, O, mrun, lrun, r, h);
    attn_lstore(g1, Kl1, Vt1, tid);
    __syncthreads();
    if (kt + 3 < nkt) attn_gload(g1, kvp, krp, kvbase + (size_t)(kt + 3) * 64, tid, head);
    attn_tile(Kl1, Vt1, qf, O, mrun, lrun, r, h);
    if (kt + 2 < nkt) attn_lstore(g0, Kl0, Vt0, tid);
    __syncthreads();
  }
  const float ltot = lrun + __shfl_xor(lrun, 32);
  const float inv = 1.f / ltot;
#pragma unroll
  for (int dvt = 0; dvt < 2; ++dvt)
#pragma unroll
    for (int g4 = 0; g4 < 4; ++g4) {
      u16* gp = &pU(P)[ltq * UC + C_GA + head * 64 + 32 * dvt + 8 * g4 + 4 * h];
      uint2 gw = *(const uint2*)gp;
      float o0 = O[dvt][4 * g4] * inv * silu_f(bflo(gw.x));
      float o1 = O[dvt][4 * g4 + 1] * inv * silu_f(bfhi(gw.x));
      float o2 = O[dvt][4 * g4 + 2] * inv * silu_f(bflo(gw.y));
      float o3 = O[dvt][4 * g4 + 3] * inv * silu_f(bfhi(gw.y));
      *(uint2*)gp = make_uint2(pk2(o0, o1), pk2(o2, o3));
    }
}

DI void convb_item(const Params& P, const Grp& G, int l, int it) {
  const int tid = otid();
  const float* cw = P.conv_b_w + (size_t)l * 3 * 512;
  for (int rep = 0; rep < 16; ++rep) {
    int c = tid + 256 * rep;
    int row = c >> 6, c8 = (c & 63) * 8;
    size_t lt = (size_t)it * 64 + row;
    int tpos = (int)(lt % G.seqlen);
    float cc[8], xx[8], pm[8], p0[8], pp[8], bb[8], gg[8];
    unpack8(*(const uint4*)&pU(P)[lt * UC + C_C + c8], cc);
    unpack8(*(const uint4*)&pU(P)[lt * UC + C_X + c8], xx);
#pragma unroll
    for (int j = 0; j < 8; ++j) p0[j] = cc[j] * xx[j];
    if (tpos > 0) {
      unpack8(*(const uint4*)&pU(P)[(lt - 1) * UC + C_C + c8], cc);
      unpack8(*(const uint4*)&pU(P)[(lt - 1) * UC + C_X + c8], xx);
#pragma unroll
      for (int j = 0; j < 8; ++j) pm[j] = cc[j] * xx[j];
    } else { for (int j = 0; j < 8; ++j) pm[j] = 0.f; }
    if (tpos < G.seqlen - 1) {
      unpack8(*(const uint4*)&pU(P)[(lt + 1) * UC + C_C + c8], cc);
      unpack8(*(const uint4*)&pU(P)[(lt + 1) * UC + C_X + c8], xx);
#pragma unroll
      for (int j = 0; j < 8; ++j) pp[j] = cc[j] * xx[j];
    } else { for (int j = 0; j < 8; ++j) pp[j] = 0.f; }
    unpack8(*(const uint4*)&pU(P)[lt * UC + C_B + c8], bb);
    u16* gp = &pU(P)[lt * UC + C_GB + c8];
    unpack8(*(const uint4*)gp, gg);
    float o[8];
#pragma unroll
    for (int j = 0; j < 8; ++j)
      o[j] = bb[j] * (pm[j] * cw[c8 + j] + p0[j] * cw[512 + c8 + j] + pp[j] * cw[1024 + c8 + j]) * silu_f(gg[j]);
    *(uint4*)gp = pack8(o);
  }
}

DI void merge_tile(const Params& P, int it, char* ldsraw) {
  u16* lds = (u16*)ldsraw;
  const int mtile = (it & 7) * 8 + ((it >> 3) & 7), ntile = it >> 6;
  const int m0 = mtile * 128, n0 = ntile * 128;
  float* Mf = pMF(P);
  u16* Mb = pKV(P);
#pragma unroll 1
  for (int br = 0; br < 3; ++br) {
    f32x16 acc[2][2];
    acc[0][0] = zero16(); acc[0][1] = zero16(); acc[1][0] = zero16(); acc[1][1] = zero16();
    gemm_mainloop(pH(P) + (size_t)m0 * 1024, 1024, pWT1(P) + (size_t)(C_MG + br * 1024 + n0) * 1024, 1024, 1024, lds, acc);
    unsigned sg[2][2][4];
#pragma unroll
    for (int a2 = 0; a2 < 2; ++a2)
#pragma unroll
      for (int b2 = 0; b2 < 2; ++b2)
#pragma unroll
        for (int i = 0; i < 4; ++i) {
          unsigned q0 = (unsigned)(sigmoid_f(acc[a2][b2][4 * i]) * 255.f + 0.5f), q1 = (unsigned)(sigmoid_f(acc[a2][b2][4 * i + 1]) * 255.f + 0.5f);
          unsigned q2 = (unsigned)(sigmoid_f(acc[a2][b2][4 * i + 2]) * 255.f + 0.5f), q3 = (unsigned)(sigmoid_f(acc[a2][b2][4 * i + 3]) * 255.f + 0.5f);
          sg[a2][b2][i] = q0 | (q1 << 8) | (q2 << 16) | (q3 << 24);
        }
    acc[0][0] = zero16(); acc[0][1] = zero16(); acc[1][0] = zero16(); acc[1][1] = zero16();
    const int ocol = (br == 0) ? C_GA : (br == 1 ? C_GB : C_Z);
    const u16* Wp = (br == 0) ? pWPA(P) : (br == 1 ? pWPB(P) : pWPC(P));
    gemm_mainloop(pU(P) + (size_t)m0 * UC + ocol, UC, Wp + (size_t)n0 * 512, 512, 512, lds, acc);
#pragma unroll
    for (int a2 = 0; a2 < 2; ++a2)
#pragma unroll
      for (int b2 = 0; b2 < 2; ++b2)
#pragma unroll
        for (int i = 0; i < 4; ++i) {
          const unsigned wq = sg[a2][b2][i];
          acc[a2][b2][4 * i] *= (float)(wq & 255u) * (1.f / 255.f);
          acc[a2][b2][4 * i + 1] *= (float)((wq >> 8) & 255u) * (1.f / 255.f);
          acc[a2][b2][4 * i + 2] *= (float)((wq >> 16) & 255u) * (1.f / 255.f);
          acc[a2][b2][4 * i + 3] *= (float)(wq >> 24) * (1.f / 255.f);
        }
    gemm_epilogue(acc, (float*)ldsraw, [&](int row, int col, float* v) {
      float* mp = Mf + (size_t)(m0 + row) * 1024 + n0 + col;
      if (br > 0) {
        float4 p0 = *(const float4*)mp, p1 = *(const float4*)(mp + 4);
        v[0] += p0.x; v[1] += p0.y; v[2] += p0.z; v[3] += p0.w; v[4] += p1.x; v[5] += p1.y; v[6] += p1.z; v[7] += p1.w;
      }
      if (br < 2) {
        *(float4*)mp = make_float4(v[0], v[1], v[2], v[3]);
        *(float4*)(mp + 4) = make_float4(v[4], v[5], v[6], v[7]);
      } else {
        *(uint4*)&Mb[(size_t)(m0 + row) * 1024 + n0 + col] = pack8(v);
      }
    });
  }
}

DI void out_tile(const Params& P, const Grp& G, int l, int it, char* ldsraw) {
  u16* lds = (u16*)ldsraw;
  const int mtile = (it & 7) * 8 + ((it >> 3) & 7), ntile = it >> 6;
  const int m0 = mtile * 128, n0 = ntile * 128;
  f32x16 acc[2][2];
  acc[0][0] = zero16(); acc[0][1] = zero16(); acc[1][0] = zero16(); acc[1][1] = zero16();
  gemm_mainloop(pKV(P) + (size_t)m0 * 1024, 1024, pWO(P) + (size_t)n0 * 1024, 1024, 1024, lds, acc);
  gemm_epilogue<4>(acc, (float*)ldsraw, [&](int row, int col, float* v) {
    int lt = m0 + row, n = n0 + col;
    int tok = G.tok0 + lt;
    int cond = G.latent ? 1 + G.seq0 + (lt >> 11) : 0;
    const float* gate = pMOD(P) + (l * 9 + cond) * 3072 + 2048 + n;
    const float* xr = x_row(P, l, tok) + n;
    float4 x0 = *(const float4*)xr, x1 = *(const float4*)(xr + 4);
    float4 g0 = *(const float4*)(gate + 4 * 55296), g1 = *(const float4*)(gate + 4 * 55296 + 4);
    float* dst = P.out + (size_t)tok * 1024 + n;
    *(float4*)dst = make_float4(x0.x + g0.x * v[0], x0.y + g0.y * v[1], x0.z + g0.z * v[2], x0.w + g0.w * v[3]);
    *(float4*)(dst + 4) = make_float4(x1.x + g1.x * v[4], x1.y + g1.y * v[5], x1.z + g1.z * v[6], x1.w + g1.w * v[7]);
  });
}

DI void final_norm_phase(const Params& P) {
  int wave = (blockIdx.x * 256 + otid()) >> 6, lane = otid() & 63, nw = gridDim.x * 4;
  for (int r = wave; r < 24576; r += nw) {
    float* xr = P.out + (size_t)r * 1024;
    float4 v[4];
    float ss = 0.f;
#pragma unroll
    for (int i = 0; i < 4; ++i) {
      v[i] = *(const float4*)(xr + i * 256 + lane * 4);
      ss += v[i].x * v[i].x + v[i].y * v[i].y + v[i].z * v[i].z + v[i].w * v[i].w;
    }
    ss = wave_sum(ss);
    float rstd = rsqrtf(ss * (1.f / 1024.f) + 1e-6f);
#pragma unroll
    for (int i = 0; i < 4; ++i) {
      int col = i * 256 + lane * 4;
      float4 gg = *(const float4*)(P.final_norm_g + col);
      *(float4*)(xr + col) = make_float4(v[i].x * rstd * gg.x, v[i].y * rstd * gg.y, v[i].z * rstd * gg.z, v[i].w * rstd * gg.w);
    }
  }
}

#define XB_TMO      128
#define XB_XCNT(j)  (256  + 64 * (j))
#define XB_XSUB(j)  (1280 + 64 * (j))
#define XB_XGEN(j)  (2304 + 64 * (j))
#define XB_TOP      3328
#define XB_TOPGEN   3392
#define XCD_BAR_WORDS 3456
#define XB_SPIN_CAP (1u << 18)
#define LAS __attribute__((address_space(3)))

__device__ __forceinline__ unsigned xb_ld(unsigned* p)              { return __hip_atomic_load(p, __ATOMIC_RELAXED, __HIP_MEMORY_SCOPE_AGENT); }
__device__ __forceinline__ unsigned xb_add(unsigned* p, unsigned v) { return __hip_atomic_fetch_add(p, v, __ATOMIC_RELAXED, __HIP_MEMORY_SCOPE_AGENT); }
__device__ __forceinline__ unsigned xb_xcc_id() { return (unsigned)__builtin_amdgcn_s_getreg((3 << 11) | 20) & 0xFu; }
#define XB_SPIN(cond, bar) do { unsigned _sp = 0; while (cond) { __builtin_amdgcn_s_sleep(1); \
    if ((++_sp & 255u) == 0u) { if (xb_ld(&(bar)[XB_TMO])) break; if (_sp > XB_SPIN_CAP) { atomicAdd(&(bar)[XB_TMO], 1u); break; } } } } while (0)

struct XcdBarrier {
    unsigned* bar; unsigned x;
    volatile LAS unsigned* st;
};

__device__ __forceinline__ XcdBarrier xcd_barrier_post(unsigned* bar, volatile LAS unsigned* st) {
    XcdBarrier b; b.bar = bar; b.x = xb_xcc_id(); b.st = st;
    if (threadIdx.x == 0) (void)xb_add(&bar[XB_XCNT(b.x)], 1u);
    return b;
}
__device__ __forceinline__ void xcd_barrier_complete(unsigned* bar, unsigned x, unsigned& nloc, unsigned& nx) {
    const unsigned G = gridDim.x * gridDim.y * gridDim.z;
    unsigned sum, cnt, mine, sp = 0u;
    for (;;) {
        sum = 0u; cnt = 0u; mine = 0u;
#pragma unroll
        for (unsigned j = 0; j < 16; ++j) { const unsigned c = xb_ld(&bar[XB_XCNT(j)]); sum += c; cnt += (c > 0u) ? 1u : 0u; mine = (j == x) ? c : mine; }
        if (sum == G) break;
        __builtin_amdgcn_s_sleep(1);
        if ((++sp & 255u) == 0u) { if (xb_ld(&bar[XB_TMO])) break; if (sp > XB_SPIN_CAP) { atomicAdd(&bar[XB_TMO], 1u); break; } }
    }
    nloc = mine > 0u ? mine : 1u; nx = cnt > 0u ? cnt : 1u;
}

__device__ __forceinline__ void xcd_barrier(const XcdBarrier& b) {
    asm volatile("s_waitcnt vmcnt(0)" ::: "memory");
    __syncthreads();
    if (threadIdx.x == 0) {
        unsigned* bar = b.bar;
        __builtin_amdgcn_s_waitcnt(0);
        unsigned nloc = b.st[0], nx = b.st[1];
        if (nloc == 0u) { xcd_barrier_complete(bar, b.x, nloc, nx); b.st[0] = nloc; b.st[1] = nx; }
        const unsigned old = xb_add(&bar[XB_XSUB(b.x)], 1u);
        const unsigned gen = old / nloc;
        if (old + 1u == (gen + 1u) * nloc) {
            __builtin_amdgcn_fence(__ATOMIC_RELEASE, "agent");
            asm volatile("s_waitcnt vmcnt(0)" ::: "memory");
            const unsigned og = xb_add(&bar[XB_TOP], 1u);
            const unsigned tg = og / nx;
            if (og + 1u == (tg + 1u) * nx) xb_add(&bar[XB_TOPGEN], 1u);
            else XB_SPIN(xb_ld(&bar[XB_TOPGEN]) == tg, bar);
            __builtin_amdgcn_fence(__ATOMIC_ACQUIRE, "agent");
            xb_add(&bar[XB_XGEN(b.x)], 1u);
            asm volatile("s_waitcnt vmcnt(0)" ::: "memory");
        } else {
            XB_SPIN(xb_ld(&bar[XB_XGEN(b.x)]) == gen, bar);
            __builtin_amdgcn_fence(__ATOMIC_ACQUIRE, "agent");
            asm volatile("s_waitcnt vmcnt(0)" ::: "memory");
        }
    }
    __syncthreads();
}

#ifndef PROBE
#define PROBE 0
#endif
#define GSYNC() do { xcd_barrier(xb); if (PROBE & 1) xcd_barrier(xb); } while (0)
__global__ void __launch_bounds__(256, 2) mega(Params P) {
  cg::grid_group grid = cg::this_grid();
  __shared__ __attribute__((aligned(16))) char lds[LDS_TOTAL];
  __shared__ __attribute__((aligned(16))) unsigned xb_words[4];
  __shared__ int s_item;
  if (threadIdx.x < 4) xb_words[threadIdx.x] = 0u;
  __syncthreads();
  const XcdBarrier xb = xcd_barrier_post((unsigned*)(P.ws + O_BAR), (volatile LAS unsigned*)xb_words);
  if (P.out == nullptr) grid.sync();
  for (int it = blockIdx.x; it < 384; it += gridDim.x) mod_item(P, it, (float*)lds);
  convert_phase(P, 0, (float*)lds);
  GSYNC();
  norm_phase(P, make_grp(0), 0, true);
  GSYNC();
  for (int l = 0; l < 2; ++l) {
    if (l == 1) { convert_phase(P, 1, (float*)lds); norm_phase(P, make_grp(0), 1); GSYNC(); }
    for (int g = 0; g < 3; ++g) {
      const Grp G = make_grp(g);
      if (l == 0 && g == 0) {
        float* md = pMOD(P);
        for (int i = blockIdx.x * 256 + threadIdx.x; i < 55296; i += gridDim.x * 256)
          md[4 * 55296 + i] = md[i] + md[55296 + i] + md[2 * 55296 + i] + md[3 * 55296 + i];
      }
      for (int rep = 0; rep < ((PROBE & 2) ? 2 : 1); ++rep) gemm1_phase(P, G, l, lds);
      GSYNC();
      for (int rep = 0; rep < ((PROBE & 4) ? 2 : 1); ++rep) {
        const int nq = 64 * 6, nkv = (G.latent ? 72 : 64) * 8, ngd = 128 * 8, nx = 128;
        for (int it = blockIdx.x; it < nq + nkv + ngd + nx; it += gridDim.x) {
          if (it < ngd) gdn_prep_item(P, G, l, it, lds);
          else if (it < ngd + nx) { const int e = it - ngd; gemm1_tile(P, G, l, e >> 1, 6 + (e & 1), lds); }
          else if (it < ngd + nx + nkv) kvexp_tile(P, G, l, it - ngd - nx, lds);
          else qproj_tile(P, G, it - ngd - nx - nkv, lds);
        }
      }
      GSYNC();
      {
        const int nsc = G.nseq * 8, nat = 512, ncv = 128;
        unsigned* ctr = (unsigned*)(P.ws + O_BAR) + (l * 3 + g);
        for (;;) {
          __syncthreads();
          if (threadIdx.x == 0) s_item = (int)atomicAdd(ctr, 1u);
          __syncthreads();
          const int it = s_item;
          if (it >= nsc + nat + ncv) break;
          if (it < nsc) gdn_scan_item(P, G, l, it);
          else if (it < nsc + nat) attn_item(P, G, it - nsc, lds);
          else convb_item(P, G, l, it - nsc - nat);
        }
      }
      GSYNC();
      stagger();
      for (int rep = 0; rep < ((PROBE & 8) ? 2 : 1); ++rep)
        for (int it = blockIdx.x; it < 512; it += gridDim.x) merge_tile(P, it, lds);
      GSYNC();
      for (int it = blockIdx.x; it < 512; it += gridDim.x) out_tile(P, G, l, it, lds);
      if (g < 2) norm_phase(P, make_grp(g + 1), l);
      GSYNC();
    }
  }
  final_norm_phase(P);
}

extern "C" void kernel_launch(void* const* d_in, const int* in_sizes, int n_in, void* d_out, int out_size,
                              void* d_ws, size_t ws_size, hipStream_t stream) {
  static int grid_blocks = 0;
  if (!grid_blocks) {
    int dev = 0, cus = 0, per_cu = 0;
    hipGetDevice(&dev);
    hipDeviceGetAttribute(&cus, hipDeviceAttributeMultiprocessorCount, dev);
    hipOccupancyMaxActiveBlocksPerMultiprocessor(&per_cu, mega, 256, 0);
    if (per_cu > 2) per_cu = 2;
    if (per_cu < 1) per_cu = 1;
    grid_blocks = cus * per_cu;
  }
  Params p{};
  const float** pin = (const float**)&p;
  for (int i = 0; i < 25; ++i) pin[i] = (const float*)d_in[i];
  p.out = (float*)d_out;
  p.ws = (char*)d_ws;
  if (WS_NEED > ws_size) { fprintf(stderr, "workspace too small: need %zu have %zu\n", (size_t)WS_NEED, ws_size); return; }
  (void)hipMemsetAsync((char*)d_ws + O_BAR, 0, 16384, stream);
  void* args[] = {&p};
  hipError_t e = hipLaunchCooperativeKernel((void*)mega, dim3(grid_blocks), dim3(256), args, 0, stream);
  if (e != hipSuccess) fprintf(stderr, "cooperative launch failed: %s (grid %d)\n", hipGetErrorString(e), grid_blocks);
}
```

```cpp
#include <hip/hip_runtime.h>
#include <hip/hip_cooperative_groups.h>
#include <cstdio>
namespace cg = cooperative_groups;

typedef unsigned short u16;
typedef __attribute__((ext_vector_type(8))) short bf16x8;
typedef __attribute__((ext_vector_type(4))) short s16x4;
typedef __attribute__((ext_vector_type(16))) float f32x16;
typedef __attribute__((ext_vector_type(2))) __bf16 bf2_t;
typedef __attribute__((ext_vector_type(4))) unsigned u32x4;

#define DI __device__ __forceinline__
#define MFMA32(a, b, c) __builtin_amdgcn_mfma_f32_32x32x16_bf16((a), (b), (c), 0, 0, 0)

constexpr int D = 1024;
constexpr int DIN = 8384;
constexpr int UC = 5312;
constexpr int TG = 8192;
constexpr int KVROWS = 9216;
constexpr int C_CQ = 0, C_CKV = 384, C_KPE = 640, C_GA = 672, C_B = 1184, C_C = 1696, C_X = 2208, C_GB = 2720,
              C_Q = 3232, C_K = 3744, C_V = 4256, C_Z = 4768, C_AB = 5280, C_MG = 5312;
constexpr int LDS_MAIN = 73728;
constexpr int LDS_TOTAL = LDS_MAIN + 4096;
constexpr size_t OUT_CKV = 25165824, OUT_KPE = 29360128, OUT_ST = 29884416;

struct Params {
  const float *x_prompt, *x_sample, *c, *cache_ckv, *cache_kpe, *state_gdn, *c_ctx, *norm_g, *w_ada, *b_ada, *w_in,
      *q_norm_g, *kv_norm_g, *w_uq, *w_ukv, *conv_b_w, *conv_qkv_w, *a_log, *dt_bias, *gdn_norm_g, *w_pa, *w_pb, *w_pc,
      *w_o, *final_norm_g;
  float* out;
  char* ws;
};
constexpr size_t al256(size_t x) { return (x + 255) & ~(size_t)255; }
constexpr size_t O_WT1 = 0;
constexpr size_t O_WUQ = O_WT1 + al256((size_t)DIN * 1024 * 2);
constexpr size_t O_WUKVF = O_WUQ + al256((size_t)768 * 384 * 2);
constexpr size_t O_WUKV = O_WUKVF + al256((size_t)1024 * 256 * 2);
constexpr size_t O_WPA = O_WUKV + al256((size_t)1024 * 256 * 2);
constexpr size_t O_WPB = O_WPA + al256((size_t)1024 * 512 * 2);
constexpr size_t O_WPC = O_WPB + al256((size_t)1024 * 512 * 2);
constexpr size_t O_WO = O_WPC + al256((size_t)1024 * 512 * 2);
constexpr size_t O_MOD = O_WO + al256((size_t)1024 * 1024 * 2);
constexpr size_t O_H = O_MOD + al256((size_t)5 * 2 * 9 * 3072 * 4);
constexpr size_t O_U = O_H + al256((size_t)TG * 1024 * 2);
constexpr size_t O_GAB = O_U + al256((size_t)TG * UC * 2);
constexpr size_t O_Q = O_GAB + al256((size_t)TG * 32 * 4);
constexpr size_t O_KV = O_Q + al256((size_t)TG * 768 * 2);
constexpr size_t O_KR = O_KV + al256((size_t)KVROWS * 1024 * 2);
constexpr size_t O_CKVC = O_KR + al256((size_t)KVROWS * 32 * 2);
constexpr size_t O_GD = O_CKVC + al256((size_t)1024 * 256 * 2);
constexpr size_t O_OF = O_GD + al256((size_t)2 * 128 * 8 * 16384 * 2);
constexpr size_t O_OR = O_OF + al256((size_t)TG * 512 * 2);
constexpr size_t O_BAR = O_OR + al256((size_t)TG * 512 * 2);
constexpr size_t WS_NEED = O_BAR + 16384;
#define WSP(T, name, off) DI T* name(const Params& P) { return (T*)(P.ws + (off)); }
WSP(u16, pWT1, O_WT1) WSP(u16, pWUQ, O_WUQ) WSP(u16, pWUKVF, O_WUKVF) WSP(u16, pWUKV, O_WUKV) WSP(u16, pWPA, O_WPA)
WSP(u16, pWPB, O_WPB) WSP(u16, pWPC, O_WPC) WSP(u16, pWO, O_WO) WSP(float, pMOD, O_MOD) WSP(u16, pH, O_H) WSP(u16, pU, O_U)
WSP(float, pGAB, O_GAB) WSP(u16, pQ, O_Q) WSP(u16, pKV, O_KV) WSP(u16, pKR, O_KR) WSP(u16, pCKVC, O_CKVC) WSP(u16, pGD, O_GD)
WSP(u16, pOF, O_OF) WSP(u16, pOR, O_OR) WSP(float, pMF, O_GD)

struct Grp { int tok0, nseq, seqlen, latent, seq0, nchunk, kvlen; };
DI Grp make_grp(int g) {
  Grp r;
  if (g == 0) { r.tok0 = 0; r.nseq = 32; r.seqlen = 256; r.latent = 0; r.seq0 = 0; r.kvlen = 256; }
  else { r.tok0 = 8192 * g; r.nseq = 4; r.seqlen = 2048; r.latent = 1; r.seq0 = (g - 1) * 4; r.kvlen = 2304; }
  r.nchunk = r.seqlen / 64;
  return r;
}

DI int otid() { int t = __builtin_amdgcn_workitem_id_x(); asm volatile("" : "+v"(t)); return t; }
DI unsigned pk2(float a, float b) { bf2_t v; v[0] = (__bf16)a; v[1] = (__bf16)b; return __builtin_bit_cast(unsigned, v); }
DI u16 f2bf(float a) { return __builtin_bit_cast(u16, (__bf16)a); }
DI float bf2f(u16 x) { return __uint_as_float(((unsigned)x) << 16); }
DI float bflo(unsigned w) { return __uint_as_float(w << 16); }
DI float bfhi(unsigned w) { return __uint_as_float(w & 0xffff0000u); }
DI void unpack8(uint4 w, float* v) {
  v[0] = bflo(w.x); v[1] = bfhi(w.x); v[2] = bflo(w.y); v[3] = bfhi(w.y);
  v[4] = bflo(w.z); v[5] = bfhi(w.z); v[6] = bflo(w.w); v[7] = bfhi(w.w);
}
DI uint4 pack8(const float* v) { return make_uint4(pk2(v[0], v[1]), pk2(v[2], v[3]), pk2(v[4], v[5]), pk2(v[6], v[7])); }
DI float silu_f(float x) { return x / (1.f + __expf(-x)); }
DI float sigmoid_f(float x) { return 1.f / (1.f + __expf(-x)); }
DI int crow(int i, int h) { return (i & 3) + 8 * (i >> 2) + 4 * h; }
DI int swap23(int k) { return (k & ~12) | ((k & 4) << 1) | ((k & 8) >> 1); }
DI float wave_sum(float v) {
  v += __shfl_xor(v, 32); v += __shfl_xor(v, 16); v += __shfl_xor(v, 8);
  v += __shfl_xor(v, 4); v += __shfl_xor(v, 2); v += __shfl_xor(v, 1);
  return v;
}
DI bf16x8 pack_frag(const f32x16& x, int s) {
  uint4 p = make_uint4(pk2(x[8 * s], x[8 * s + 1]), pk2(x[8 * s + 2], x[8 * s + 3]), pk2(x[8 * s + 4], x[8 * s + 5]),
                       pk2(x[8 * s + 6], x[8 * s + 7]));
  return __builtin_bit_cast(bf16x8, p);
}
DI f32x16 zero16() { f32x16 z; for (int i = 0; i < 16; ++i) z[i] = 0.f; return z; }
DI void rope8(float* v, int pi0, int tpos) {
#pragma unroll
  for (int j = 0; j < 4; ++j) {
    int pi = pi0 + j;
    int f = pi & 7;
    float pos = (float)((pi < 8) ? (tpos >> 6) : (tpos & 63));
    float ang = pos * __builtin_amdgcn_exp2f(-(float)f * 1.6609640474436813f);
    float cs = __cosf(ang), sn = __sinf(ang);
    float x0 = v[2 * j], x1 = v[2 * j + 1];
    v[2 * j] = x0 * cs - x1 * sn;
    v[2 * j + 1] = x0 * sn + x1 * cs;
  }
}

DI void mod_item(const Params& P, int it, float* lds) {
  const int kq4 = it & 3, cg = (it >> 2) % 48, l = it / 192;
  const int c0 = cg * 64;
  int tid = otid();
  float* sc = lds;
  for (int i = tid; i < 9 * 256; i += 256) {
    int b = i >> 8, k = kq4 * 256 + (i & 255);
    float cv = (b == 0) ? P.c_ctx[k] : P.c[(b - 1) * 1024 + k];
    sc[i] = silu_f(cv);
  }
  __syncthreads();
  int col = tid & 63, kq = tid >> 6;
  float acc[9];
#pragma unroll
  for (int b = 0; b < 9; ++b) acc[b] = 0.f;
  const float* w = P.w_ada + (size_t)l * 1024 * 3072 + (size_t)(kq4 * 256 + kq * 64) * 3072 + c0 + col;
#pragma unroll 8
  for (int k = 0; k < 64; ++k) {
    float wv = w[(size_t)k * 3072];
#pragma unroll
    for (int b = 0; b < 9; ++b) acc[b] += sc[b * 256 + kq * 64 + k] * wv;
  }
  float* red = lds + 9 * 256;
#pragma unroll
  for (int b = 0; b < 9; ++b) red[(kq * 9 + b) * 64 + col] = acc[b];
  __syncthreads();
  for (int i = tid; i < 9 * 64; i += 256) {
    int b = i >> 6, cc = i & 63;
    float s = red[(0 * 9 + b) * 64 + cc] + red[(1 * 9 + b) * 64 + cc] + red[(2 * 9 + b) * 64 + cc] + red[(3 * 9 + b) * 64 + cc];
    if (kq4 == 0) s += P.b_ada[l * 3072 + c0 + cc];
    pMOD(P)[(size_t)kq4 * 55296 + (l * 9 + b) * 3072 + c0 + cc] = s;
  }
  __syncthreads();
}
DI float4 mod4(const float* p) {
  float4 a = *(const float4*)p, b = *(const float4*)(p + 55296), c = *(const float4*)(p + 2 * 55296), d = *(const float4*)(p + 3 * 55296);
  return make_float4(a.x + b.x + c.x + d.x, a.y + b.y + c.y + d.y, a.z + b.z + c.z + d.z, a.w + b.w + c.w + d.w);
}

DI void convT_tile(const float* __restrict__ src, int K, int N, u16* __restrict__ dst, const float* __restrict__ g, int tk, int tn, float* lds) {
  int tid = otid();
  int k0 = tk * 64, n0 = tn * 64;
  for (int i = tid; i < 4096; i += 256) {
    int kk = i >> 6, nn = i & 63;
    float v = src[(size_t)(k0 + kk) * N + n0 + nn];
    if (g) v *= g[k0 + kk];
    lds[kk * 65 + nn] = v;
  }
  __syncthreads();
  for (int i = tid; i < 512; i += 256) {
    int nn = i >> 3, kc = (i & 7) * 8;
    float v[8];
#pragma unroll
    for (int j = 0; j < 8; ++j) v[j] = lds[(kc + j) * 65 + nn];
    *(uint4*)&dst[(size_t)(n0 + nn) * K + k0 + kc] = pack8(v);
  }
  __syncthreads();
}

DI void convert_phase(const Params& P, int l, float* lds) {
  for (int it = blockIdx.x; it < 2936; it += gridDim.x) {
    int i = it;
    if (i < 2096) { convT_tile(P.w_in + (size_t)l * 1024 * DIN, 1024, DIN, pWT1(P), nullptr, i % 16, i / 16, lds); continue; }
    i -= 2096;
    if (i < 72) { convT_tile(P.w_uq + (size_t)l * 384 * 768, 384, 768, pWUQ(P), P.q_norm_g + l * 384, i % 6, i / 6, lds); continue; }
    i -= 72;
    if (i < 64) { convT_tile(P.w_ukv + (size_t)l * 256 * 1024, 256, 1024, pWUKVF(P), P.kv_norm_g + l * 256, i % 4, i / 4, lds); continue; }
    i -= 64;
    if (i < 64) { convT_tile(P.w_ukv + (size_t)l * 256 * 1024, 256, 1024, pWUKV(P), nullptr, i % 4, i / 4, lds); continue; }
    i -= 64;
    if (i < 128) { convT_tile(P.w_pa + (size_t)l * 512 * 1024, 512, 1024, pWPA(P), nullptr, i % 8, i / 8, lds); continue; }
    i -= 128;
    if (i < 128) { convT_tile(P.w_pb + (size_t)l * 512 * 1024, 512, 1024, pWPB(P), nullptr, i % 8, i / 8, lds); continue; }
    i -= 128;
    if (i < 128) { convT_tile(P.w_pc + (size_t)l * 512 * 1024, 512, 1024, pWPC(P), nullptr, i % 8, i / 8, lds); continue; }
    i -= 128;
    convT_tile(P.w_o + (size_t)l * 1024 * 1024, 1024, 1024, pWO(P), nullptr, i % 16, i / 16, lds);
  }
}

DI const float* x_row(const Params& P, int l, int tok) {
  if (l == 0) return (tok < 8192) ? P.x_prompt + (size_t)tok * 1024 : P.x_sample + (size_t)(tok - 8192) * 1024;
  return P.out + (size_t)tok * 1024;
}
DI void norm_phase(const Params& P, const Grp& G, int l, bool first = false) {
  int wave = (blockIdx.x * 256 + otid()) >> 6, lane = otid() & 63, nw = gridDim.x * 4;
  const float* ng = P.norm_g + l * 1024;
  for (int r = wave; r < TG; r += nw) {
    int tok = G.tok0 + r;
    const float* xr = x_row(P, l, tok);
    int cond = G.latent ? 1 + G.seq0 + (r >> 11) : 0;
    const float* mod = pMOD(P) + (l * 9 + cond) * 3072;
    float4 v[4];
    float ss = 0.f;
#pragma unroll
    for (int i = 0; i < 4; ++i) {
      v[i] = *(const float4*)(xr + i * 256 + lane * 4);
      ss += v[i].x * v[i].x + v[i].y * v[i].y + v[i].z * v[i].z + v[i].w * v[i].w;
    }
    ss = wave_sum(ss);
    float rstd = rsqrtf(ss * (1.f / 1024.f) + 1e-6f);
#pragma unroll
    for (int i = 0; i < 4; ++i) {
      int col = i * 256 + lane * 4;
      float4 gg = *(const float4*)(ng + col);
      float4 sh = first ? mod4(mod + col) : *(const float4*)(mod + 4 * 55296 + col);
      float4 scl = first ? mod4(mod + 1024 + col) : *(const float4*)(mod + 4 * 55296 + 1024 + col);
      float h0 = v[i].x * rstd * gg.x * (1.f + scl.x) + sh.x;
      float h1 = v[i].y * rstd * gg.y * (1.f + scl.y) + sh.y;
      float h2 = v[i].z * rstd * gg.z * (1.f + scl.z) + sh.z;
      float h3 = v[i].w * rstd * gg.w * (1.f + scl.w) + sh.w;
      *(uint2*)&pH(P)[(size_t)r * 1024 + col] = make_uint2(pk2(h0, h1), pk2(h2, h3));
    }
  }
  if (G.latent) {
    int gt = blockIdx.x * 256 + otid(), nth = gridDim.x * 256;
    for (int i = gt; i < 1024 * 256; i += nth) {
      int row = i >> 8, cc = i & 255;
      int sl = row >> 8, p = row & 255;
      pCKVC(P)[i] = f2bf(P.cache_ckv[(((size_t)(G.seq0 + sl) * 2 + l) * 256 + p) * 256 + cc]);
    }
    for (int i = gt; i < 1024 * 32; i += nth) {
      int row = i >> 5, cc = i & 31;
      int sl = row >> 8, p = row & 255;
      pKR(P)[((size_t)sl * 2304 + p) * 32 + cc] = f2bf(P.cache_kpe[(((size_t)(G.seq0 + sl) * 2 + l) * 256 + p) * 32 + cc]);
    }
  }
}

DI void g_load(u32x4 (&ra)[4], u32x4 (&rb)[4], const u16* ga, const u16* gb, size_t sa32, size_t sb32, int kt) {
#pragma unroll
  for (int i = 0; i < 4; ++i) {
    ra[i] = *(const u32x4*)(ga + i * sa32 + kt * 64);
    rb[i] = *(const u32x4*)(gb + i * sb32 + kt * 64);
  }
}
DI void l_store(const u32x4 (&ra)[4], const u32x4 (&rb)[4], u16* dA, u16* dB, int lrow, int lcol) {
#pragma unroll
  for (int i = 0; i < 4; ++i) {
    *(u32x4*)&dA[(lrow + 32 * i) * 72 + lcol] = ra[i];
    *(u32x4*)&dB[(lrow + 32 * i) * 72 + lcol] = rb[i];
  }
}
DI void t_compute(const u16* cA, const u16* cB, f32x16 (&acc)[2][2]) {
#pragma unroll
  for (int s = 0; s < 4; ++s) {
    bf16x8 a0 = *(const bf16x8*)(cA + s * 16);
    bf16x8 a1 = *(const bf16x8*)(cA + 32 * 72 + s * 16);
    bf16x8 b0 = *(const bf16x8*)(cB + s * 16);
    bf16x8 b1 = *(const bf16x8*)(cB + 32 * 72 + s * 16);
    acc[0][0] = MFMA32(a0, b0, acc[0][0]);
    acc[0][1] = MFMA32(a0, b1, acc[0][1]);
    acc[1][0] = MFMA32(a1, b0, acc[1][0]);
    acc[1][1] = MFMA32(a1, b1, acc[1][1]);
  }
}
DI void gemm_mainloop(const u16* __restrict__ A, int lda, const u16* __restrict__ B, int ldb, int K, u16* lds, f32x16 (&acc)[2][2]) {
  const int tid = otid(), lane = tid & 63, w = tid >> 6, wr = w >> 1, wc = w & 1, r = lane & 31, h = lane >> 5;
  u16* sA = lds;
  u16* sB = lds + 2 * 128 * 72;
  const int lrow = tid >> 3, lcol = (tid & 7) * 8;
  const u16* ga = A + (size_t)lrow * lda + lcol;
  const u16* gb = B + (size_t)lrow * ldb + lcol;
  const size_t sa32 = (size_t)32 * lda, sb32 = (size_t)32 * ldb;
  u32x4 ra0[4], rb0[4], ra1[4], rb1[4];
  const int nk = K >> 6;
  const u16* cA = sA + (wr * 64 + r) * 72 + h * 8;
  const u16* cB = sB + (wc * 64 + r) * 72 + h * 8;
  g_load(ra0, rb0, ga, gb, sa32, sb32, 0);
  g_load(ra1, rb1, ga, gb, sa32, sb32, 1);
  l_store(ra0, rb0, sA, sB, lrow, lcol);
  __syncthreads();
  for (int kt = 0; kt < nk; kt += 2) {
    if (kt + 2 < nk) g_load(ra0, rb0, ga, gb, sa32, sb32, kt + 2);
    t_compute(cA, cB, acc);
    l_store(ra1, rb1, sA + 128 * 72, sB + 128 * 72, lrow, lcol);
    __syncthreads();
    if (kt + 3 < nk) g_load(ra1, rb1, ga, gb, sa32, sb32, kt + 3);
    t_compute(cA + 128 * 72, cB + 128 * 72, acc);
    if (kt + 2 < nk) l_store(ra0, rb0, sA, sB, lrow, lcol);
    __syncthreads();
  }
}

DI void gemm_mainloop1(const u16* __restrict__ A, int lda, const u16* __restrict__ B, int ldb, int K, u16* lds, f32x16 (&acc)[2][2]) {
  const int tid = otid(), lane = tid & 63, w = tid >> 6, wr = w >> 1, wc = w & 1, r = lane & 31, h = lane >> 5;
  u16* sA = lds;
  u16* sB = lds + 2 * 128 * 72;
  const int lrow = tid >> 3, lcol = (tid & 7) * 8;
  const u16* ga = A + (size_t)lrow * lda + lcol;
  const u16* gb = B + (size_t)lrow * ldb + lcol;
  const size_t sa32 = (size_t)32 * lda, sb32 = (size_t)32 * ldb;
  u32x4 ra[4], rb[4];
  const int nk = K >> 6;
  const u16* cA = sA + (wr * 64 + r) * 72 + h * 8;
  const u16* cB = sB + (wc * 64 + r) * 72 + h * 8;
  g_load(ra, rb, ga, gb, sa32, sb32, 0);
  l_store(ra, rb, sA, sB, lrow, lcol);
  __syncthreads();
  for (int kt = 0; kt < nk; ++kt) {
    const int cur = kt & 1;
    if (kt + 1 < nk) g_load(ra, rb, ga, gb, sa32, sb32, kt + 1);
    t_compute(cA + cur * 128 * 72, cB + cur * 128 * 72, acc);
    if (kt + 1 < nk) l_store(ra, rb, sA + (cur ^ 1) * 128 * 72, sB + (cur ^ 1) * 128 * 72, lrow, lcol);
    __syncthreads();
  }
}

template <int UNR = 2, class F>
DI void gemm_epilogue(f32x16 (&acc)[2][2], float* cs, F f) {
  const int tid = otid(), lane = tid & 63, w = tid >> 6, wr = w >> 1, wc = w & 1, r = lane & 31, h = lane >> 5;
#pragma unroll
  for (int mt = 0; mt < 2; ++mt)
#pragma unroll
    for (int nt = 0; nt < 2; ++nt)
#pragma unroll
      for (int i = 0; i < 16; ++i) cs[(wr * 64 + mt * 32 + crow(i, h)) * 132 + wc * 64 + nt * 32 + r] = acc[mt][nt][i];
  __syncthreads();
#pragma unroll UNR
  for (int it = 0; it < 8; ++it) {
    int c = tid + 256 * it;
    int row = c >> 4, col = (c & 15) * 8;
    float v[8];
    float4 a = *(const float4*)&cs[row * 132 + col];
    float4 b = *(const float4*)&cs[row * 132 + col + 4];
    v[0] = a.x; v[1] = a.y; v[2] = a.z; v[3] = a.w; v[4] = b.x; v[5] = b.y; v[6] = b.z; v[7] = b.w;
    f(row, col, v);
  }
  __syncthreads();
}

DI void stagger() { if (blockIdx.x >= (gridDim.x >> 1)) __builtin_amdgcn_s_sleep(24); }
DI void gemm1_tile(const Params& P, const Grp& G, int l, int mtile, int ntile, char* ldsraw) {
  u16* lds = (u16*)ldsraw;
  {
    const int m0 = mtile * 128, n0 = ntile * 128;
    f32x16 acc[2][2];
    acc[0][0] = zero16(); acc[0][1] = zero16(); acc[1][0] = zero16(); acc[1][1] = zero16();
    gemm_mainloop(pH(P) + (size_t)m0 * 1024, 1024, pWT1(P) + (size_t)n0 * 1024, 1024, 1024, lds, acc);
    gemm_epilogue(acc, (float*)ldsraw, [&](int row, int col, float* v) {
      int n = n0 + col;
      if (n >= UC) return;
      int lt = m0 + row;
      *(uint4*)&pU(P)[(size_t)lt * UC + n] = pack8(v);
      if (n >= C_KPE && n < C_KPE + 32) {
        int cc = n - C_KPE;
        int sl = lt / G.seqlen, tpos = lt % G.seqlen;
        if (!G.latent) {
          float* dst = P.out + OUT_KPE + (((size_t)sl * 2 + l) * 256 + tpos) * 32 + cc;
          *(float4*)dst = make_float4(v[0], v[1], v[2], v[3]);
          *(float4*)(dst + 4) = make_float4(v[4], v[5], v[6], v[7]);
          *(uint4*)&pKR(P)[(size_t)lt * 32 + cc] = pack8(v);
        } else {
          rope8(v, cc >> 1, tpos);
          *(uint4*)&pKR(P)[((size_t)sl * 2304 + 256 + tpos) * 32 + cc] = pack8(v);
        }
      } else if (n >= C_AB) {
        float* dst = pGAB(P) + (size_t)lt * 32 + (n - C_AB);
        *(float4*)dst = make_float4(v[0], v[1], v[2], v[3]);
        *(float4*)(dst + 4) = make_float4(v[4], v[5], v[6], v[7]);
      }
    });
  }
}
DI void gemm1_phase(const Params& P, const Grp& G, int l, char* ldsraw) {
  for (int it = blockIdx.x; it < 64 * 40; it += gridDim.x) {
    int xcd = it & 7, j = it >> 3;
    int sj = j / 40, q = j % 40;
    int S = xcd + 8 * sj;
    int mtile = (S & 7) * 8 + (q & 7), nidx = (S >> 3) * 5 + (q >> 3);
    gemm1_tile(P, G, l, mtile, nidx < 6 ? nidx : nidx + 2, ldsraw);
  }
}

DI void rowstat(const u16* __restrict__ A, int lda, int K, float* rs) {
  int tid = otid();
  int row = tid >> 1, half = tid & 1;
  const u16* p = A + (size_t)row * lda + half * (K >> 1);
  float ss = 0.f;
  for (int c = 0; c < (K >> 4); ++c) {
    float v[8];
    unpack8(*(const uint4*)(p + c * 8), v);
#pragma unroll
    for (int j = 0; j < 8; ++j) ss += v[j] * v[j];
  }
  ss += __shfl_xor(ss, 1);
  if (half == 0) rs[row] = rsqrtf(ss / (float)K + 1e-6f);
  __syncthreads();
}

DI void qproj_tile(const Params& P, const Grp& G, int it, char* ldsraw) {
  u16* lds = (u16*)ldsraw;
  float* rs = (float*)(ldsraw + LDS_MAIN);
  int mtile = it / 6, ntile = it % 6;
  int m0 = mtile * 128, n0 = ntile * 128;
  const u16* A = pU(P) + (size_t)m0 * UC + C_CQ;
  rowstat(A, UC, 384, rs);
  f32x16 acc[2][2];
  acc[0][0] = zero16(); acc[0][1] = zero16(); acc[1][0] = zero16(); acc[1][1] = zero16();
  gemm_mainloop(A, UC, pWUQ(P) + (size_t)n0 * 384, 384, 384, lds, acc);
  gemm_epilogue(acc, (float*)ldsraw, [&](int row, int col, float* v) {
    int n = n0 + col, lt = m0 + row;
    float s = rs[row];
#pragma unroll
    for (int j = 0; j < 8; ++j) v[j] *= s;
    int d = n % 96;
    if (G.latent && d >= 64) rope8(v, (d - 64) >> 1, lt & 2047);
    *(uint4*)&pQ(P)[(size_t)lt * 768 + n] = pack8(v);
  });
}

DI void kvexp_tile(const Params& P, const Grp& G, int l, int it, char* ldsraw) {
  u16* lds = (u16*)ldsraw;
  float* rs = (float*)(ldsraw + LDS_MAIN);
  int mtile = it >> 3, ntile = it & 7;
  int n0 = ntile * 128;
  const bool cache = mtile >= 64;
  int m0 = (cache ? (mtile - 64) : mtile) * 128;
  const u16* A;
  int lda;
  const u16* W;
  if (!cache) {
    A = pU(P) + (size_t)m0 * UC + C_CKV; lda = UC; W = pWUKVF(P);
    rowstat(A, UC, 256, rs);
  } else {
    A = pCKVC(P) + (size_t)m0 * 256; lda = 256; W = pWUKV(P);
    if (otid() < 128) rs[otid()] = 1.f;
    __syncthreads();
  }
  f32x16 acc[2][2];
  acc[0][0] = zero16(); acc[0][1] = zero16(); acc[1][0] = zero16(); acc[1][1] = zero16();
  gemm_mainloop(A, lda, W + (size_t)n0 * 256, 256, 256, lds, acc);
  gemm_epilogue(acc, (float*)ldsraw, [&](int row, int col, float* v) {
    int n = n0 + col, lr = m0 + row;
    float s = rs[row];
#pragma unroll
    for (int j = 0; j < 8; ++j) v[j] *= s;
    size_t kvrow;
    if (!G.latent) kvrow = lr;
    else if (!cache) kvrow = (size_t)(lr >> 11) * 2304 + 256 + (lr & 2047);
    else kvrow = (size_t)(lr >> 8) * 2304 + (lr & 255);
    *(uint4*)&pKV(P)[kvrow * 1024 + n] = pack8(v);
  });
  if (!G.latent && ntile == 0) {
    const float* kg = P.kv_norm_g + l * 256;
    for (int c = otid(); c < 128 * 32; c += 256) {
      int row = c >> 5, c8 = (c & 31) * 8;
      int lt = m0 + row;
      float v[8];
      unpack8(*(const uint4*)&pU(P)[(size_t)lt * UC + C_CKV + c8], v);
      float s = rs[row];
      float* dst = P.out + OUT_CKV + (((size_t)(lt >> 8) * 2 + l) * 256 + (lt & 255)) * 256 + c8;
      *(float4*)dst = make_float4(v[0] * s * kg[c8], v[1] * s * kg[c8 + 1], v[2] * s * kg[c8 + 2], v[3] * s * kg[c8 + 3]);
      *(float4*)(dst + 4) = make_float4(v[4] * s * kg[c8 + 4], v[5] * s * kg[c8 + 5], v[6] * s * kg[c8 + 6], v[7] * s * kg[c8 + 7]);
    }
    __syncthreads();
  }
}

DI f32x16 mm64_tile(const u16* A, const u16* Bt, int tm, int tn, int r, int h) {
  f32x16 acc = zero16();
  const u16* pa = A + (32 * tm + r) * 72 + 8 * h;
  const u16* pb = Bt + (32 * tn + r) * 72 + 8 * h;
#pragma unroll
  for (int s = 0; s < 4; ++s) acc = MFMA32(*(const bf16x8*)(pa + 16 * s), *(const bf16x8*)(pb + 16 * s), acc);
  return acc;
}

DI void gdn_prep_item(const Params& P, const Grp& G, int l, int it, char* ldsraw) {
  const int tid0 = otid();
  int t2 = it;
  const int N = G.nchunk;
  const int ctok = t2 % N; t2 /= N;
  const int head = t2 & 7, sl = t2 >> 3;
  u16* lds = (u16*)ldsraw;
  u16* Kn = lds;
  u16* Qn = lds + 4608;
  u16* VTb = lds + 9216;
  u16* KTb = lds + 13824;
  u16* KdT = lds + 18432;
  u16* AT = lds + 23040;
  float* Lf = (float*)(lds + 27648);
  float* sm = (float*)(ldsraw + LDS_MAIN);
  float* s_gc = sm; float* s_beta = sm + 64; float* s_eg = sm + 128; float* s_ekd = sm + 192;

  unsigned yp[3][8];
  {
    const int i = tid0 >> 2, part = tid0 & 3;
    const int tpos = ctok * 64 + i;
    const size_t lt = (size_t)sl * G.seqlen + tpos;
#pragma unroll
    for (int m = 0; m < 3; ++m) {
      const int cb = C_Q + m * 512 + head * 64 + part * 16;
      const float* cw = P.conv_qkv_w + (size_t)l * 3 * 1536 + m * 512 + head * 64 + part * 16;
      float y[16];
#pragma unroll
      for (int hf = 0; hf < 2; ++hf) {
        float xc[8], xm[8], xp[8];
        unpack8(*(const uint4*)&pU(P)[lt * UC + cb + hf * 8], xc);
        if (tpos > 0) unpack8(*(const uint4*)&pU(P)[(lt - 1) * UC + cb + hf * 8], xm);
        else { for (int j = 0; j < 8; ++j) xm[j] = 0.f; }
        if (tpos < G.seqlen - 1) unpack8(*(const uint4*)&pU(P)[(lt + 1) * UC + cb + hf * 8], xp);
        else { for (int j = 0; j < 8; ++j) xp[j] = 0.f; }
        float w0[8], w1[8], w2[8];
        *(float4*)&w0[0] = *(const float4*)(cw + hf * 8); *(float4*)&w0[4] = *(const float4*)(cw + hf * 8 + 4);
        *(float4*)&w1[0] = *(const float4*)(cw + 1536 + hf * 8); *(float4*)&w1[4] = *(const float4*)(cw + 1536 + hf * 8 + 4);
        *(float4*)&w2[0] = *(const float4*)(cw + 3072 + hf * 8); *(float4*)&w2[4] = *(const float4*)(cw + 3072 + hf * 8 + 4);
#pragma unroll
        for (int j = 0; j < 8; ++j) y[hf * 8 + j] = silu_f(xm[j] * w0[j] + xc[j] * w1[j] + xp[j] * w2[j]);
      }
      if (m < 2) {
        float sq = 0.f;
#pragma unroll
        for (int j = 0; j < 16; ++j) sq += y[j] * y[j];
        sq += __shfl_xor(sq, 1); sq += __shfl_xor(sq, 2);
        float iq = rsqrtf(sq + 1e-6f) * ((m == 0) ? 0.125f : 1.f);
#pragma unroll
        for (int j = 0; j < 16; ++j) y[j] *= iq;
      }
#pragma unroll
      for (int j = 0; j < 8; ++j) yp[m][j] = pk2(y[2 * j], y[2 * j + 1]);
    }
  }
  int ndir = 2;
  asm volatile("" : "+s"(ndir));
  for (int dir = 0; dir < ndir; ++dir) {
  const int tid = otid(), lane = tid & 63, w = tid >> 6, r = lane & 31, h = lane >> 5;
  const int i = tid >> 2, part = tid & 3;
  if (tid < 64) {
    const int ti = tid;
    const int tp = dir ? (ctok * 64 + 63 - ti) : (ctok * 64 + ti);
    const size_t ltg = (size_t)sl * G.seqlen + tp;
    float a = pGAB(P)[ltg * 32 + dir * 8 + head];
    float b = pGAB(P)[ltg * 32 + 16 + dir * 8 + head];
    float xs = a + P.dt_bias[l * 16 + dir * 8 + head];
    float sp = (xs > 20.f) ? xs : log1pf(__expf(xs));
    float g = -__expf(P.a_log[l * 16 + dir * 8 + head]) * sp;
#pragma unroll
    for (int off = 1; off < 64; off <<= 1) {
      float t = __shfl_up(g, off);
      if (ti >= off) g += t;
    }
    float gl = __shfl(g, 63);
    s_gc[ti] = g; s_beta[ti] = sigmoid_f(b); s_eg[ti] = __expf(g); s_ekd[ti] = __expf(gl - g);
  }
  __syncthreads();
  {
    const int ri = dir ? (63 - i) : i;
    const float be = s_beta[ri], eg = s_eg[ri], ekd = s_ekd[ri];
    *(uint4*)&Qn[ri * 72 + part * 16] = make_uint4(yp[0][0], yp[0][1], yp[0][2], yp[0][3]);
    *(uint4*)&Qn[ri * 72 + part * 16 + 8] = make_uint4(yp[0][4], yp[0][5], yp[0][6], yp[0][7]);
    *(uint4*)&Kn[ri * 72 + part * 16] = make_uint4(yp[1][0], yp[1][1], yp[1][2], yp[1][3]);
    *(uint4*)&Kn[ri * 72 + part * 16 + 8] = make_uint4(yp[1][4], yp[1][5], yp[1][6], yp[1][7]);
#pragma unroll
    for (int j = 0; j < 8; ++j) {
      const int cc = part * 16 + 2 * j;
      const float k0 = bflo(yp[1][j]), k1 = bfhi(yp[1][j]), v0 = bflo(yp[2][j]), v1 = bfhi(yp[2][j]);
      KTb[cc * 72 + ri] = f2bf(k0 * be * eg);  KTb[(cc + 1) * 72 + ri] = f2bf(k1 * be * eg);
      KdT[cc * 72 + ri] = f2bf(k0 * ekd);      KdT[(cc + 1) * 72 + ri] = f2bf(k1 * ekd);
      VTb[cc * 72 + ri] = f2bf(v0 * be);       VTb[(cc + 1) * 72 + ri] = f2bf(v1 * be);
    }
  }
  __syncthreads();
  const int tm = w >> 1, tn = w & 1;
  {
    f32x16 aK = mm64_tile(Kn, Kn, tm, tn, r, h);
    f32x16 aQ = mm64_tile(Qn, Kn, tm, tn, r, h);
    const int jj = 32 * tn + r;
    const float gcj = s_gc[jj];
#pragma unroll
    for (int ii = 0; ii < 16; ++ii) {
      const int ri = 32 * tm + crow(ii, h);
      float dec = (ri >= jj) ? __expf(s_gc[ri] - gcj) : 0.f;
      Lf[ri * 72 + jj] = (ri > jj) ? s_beta[ri] * aK[ii] * dec : 0.f;
      AT[ri * 72 + jj] = f2bf(aQ[ii] * dec);
    }
  }
  __syncthreads();
  float* Pf = (float*)Kn;
  if (w == 0) {
    const int b = lane >> 4, c = lane & 15;
    float t[16];
#pragma unroll
    for (int a = 0; a < 16; ++a) {
      float s = (a == c) ? 1.f : 0.f;
#pragma unroll
      for (int j = 0; j < a; ++j) s -= Lf[(16 * b + a) * 72 + 16 * b + j] * t[j];
      t[a] = s;
    }
#pragma unroll
    for (int a = 0; a < 16; ++a) Lf[(16 * b + a) * 72 + 16 * b + c] = t[a];
  }
  __syncthreads();
  for (int idx = tid; idx < 512; idx += 256) {
    const int p = idx >> 8, a = (idx >> 4) & 15, j = idx & 15;
    float s = 0.f;
#pragma unroll
    for (int k = 0; k < 16; ++k) s += Lf[(32 * p + 16 + a) * 72 + 32 * p + k] * Lf[(32 * p + k) * 72 + 32 * p + j];
    Pf[p * 256 + a * 16 + j] = s;
  }
  __syncthreads();
  for (int idx = tid; idx < 512; idx += 256) {
    const int p = idx >> 8, a = (idx >> 4) & 15, j = idx & 15;
    float s = 0.f;
#pragma unroll
    for (int k = 0; k < 16; ++k) s += Lf[(32 * p + 16 + a) * 72 + 32 * p + 16 + k] * Pf[p * 256 + k * 16 + j];
    Lf[(32 * p + 16 + a) * 72 + 32 * p + j] = -s;
  }
  __syncthreads();
  if (w == 0) {
    f32x16 acc = zero16();
#pragma unroll
    for (int s2 = 0; s2 < 16; ++s2)
      acc = __builtin_amdgcn_mfma_f32_32x32x2f32(Lf[(32 + r) * 72 + 2 * s2 + h], Lf[(2 * s2 + h) * 72 + r], acc, 0, 0, 0);
#pragma unroll
    for (int ii = 0; ii < 16; ++ii) Pf[crow(ii, h) * 32 + r] = acc[ii];
  }
  __syncthreads();
  if (w == 0) {
    f32x16 acc = zero16();
#pragma unroll
    for (int s2 = 0; s2 < 16; ++s2)
      acc = __builtin_amdgcn_mfma_f32_32x32x2f32(Lf[(32 + r) * 72 + 32 + 2 * s2 + h], Pf[(2 * s2 + h) * 32 + r], acc, 0, 0, 0);
#pragma unroll
    for (int ii = 0; ii < 16; ++ii) Lf[(32 + crow(ii, h)) * 72 + r] = -acc[ii];
  }
  __syncthreads();
  u16* Tb = Kn;
  for (int idx = tid; idx < 4096; idx += 256) {
    const int a = idx >> 6, j = idx & 63;
    Tb[a * 72 + j] = f2bf(Lf[a * 72 + j]);
  }
  __syncthreads();
  u16* UT = (u16*)Lf;
  u16* WT = UT + 4608;
  {
    f32x16 aU = mm64_tile(Tb, VTb, tm, tn, r, h);
    f32x16 aW = mm64_tile(Tb, KTb, tm, tn, r, h);
    __syncthreads();
#pragma unroll
    for (int g4 = 0; g4 < 4; ++g4) {
      const int ci = 32 * tm + 8 * g4 + 4 * h;
      *(uint2*)&UT[(32 * tn + r) * 72 + ci] = make_uint2(pk2(aU[4 * g4], aU[4 * g4 + 1]), pk2(aU[4 * g4 + 2], aU[4 * g4 + 3]));
      *(uint2*)&WT[(32 * tn + r) * 72 + ci] = make_uint2(pk2(aW[4 * g4], aW[4 * g4 + 1]), pk2(aW[4 * g4 + 2], aW[4 * g4 + 3]));
    }
  }
  __syncthreads();
  {
    const int cdir = dir ? (N - 1 - ctok) : ctok;
    u16* gd = pGD(P) + ((((size_t)dir * G.nseq + sl) * 8 + head) * N + cdir) * 16384;
    f32x16 a1 = mm64_tile(AT, WT, tm, tn, r, h);
    f32x16 a3 = mm64_tile(KdT, WT, tm, tn, r, h);
    const int cc = 32 * tn + r;
    const int pc = swap23(cc);
    const float egl = s_eg[63];
#pragma unroll
    for (int ii = 0; ii < 16; ++ii) {
      const int ri = 32 * tm + crow(ii, h);
      float qe = bf2f(Qn[ri * 72 + cc]) * s_eg[ri] - a1[ii];
      float mc = ((ri == cc) ? egl : 0.f) - a3[ii];
      gd[ri * 64 + pc] = f2bf(qe);
      gd[4096 + ri * 64 + pc] = f2bf(mc);
    }
    f32x16 a2 = mm64_tile(AT, UT, tm, tn, r, h);
    f32x16 a4 = mm64_tile(KdT, UT, tm, tn, r, h);
    u16* o3 = gd + 3 * 4096 + ((tm * 2 + tn) * 64 + lane) * 16;
    u16* o2 = gd + 2 * 4096 + ((tm * 2 + tn) * 64 + lane) * 16;
    *(uint4*)o3 = make_uint4(pk2(a2[0], a2[1]), pk2(a2[2], a2[3]), pk2(a2[4], a2[5]), pk2(a2[6], a2[7]));
    *(uint4*)(o3 + 8) = make_uint4(pk2(a2[8], a2[9]), pk2(a2[10], a2[11]), pk2(a2[12], a2[13]), pk2(a2[14], a2[15]));
    *(uint4*)o2 = make_uint4(pk2(a4[0], a4[1]), pk2(a4[2], a4[3]), pk2(a4[4], a4[5]), pk2(a4[6], a4[7]));
    *(uint4*)(o2 + 8) = make_uint4(pk2(a4[8], a4[9]), pk2(a4[10], a4[11]), pk2(a4[12], a4[13]), pk2(a4[14], a4[15]));
  }
  __syncthreads();
  }
}

DI f32x16 unpack16(const u16* p) {
  uint4 a = *(const uint4*)p, b = *(const uint4*)(p + 8);
  f32x16 v;
  v[0] = bflo(a.x); v[1] = bfhi(a.x); v[2] = bflo(a.y); v[3] = bfhi(a.y); v[4] = bflo(a.z); v[5] = bfhi(a.z); v[6] = bflo(a.w); v[7] = bfhi(a.w);
  v[8] = bflo(b.x); v[9] = bfhi(b.x); v[10] = bflo(b.y); v[11] = bfhi(b.y); v[12] = bflo(b.z); v[13] = bfhi(b.z); v[14] = bflo(b.w); v[15] = bfhi(b.w);
  return v;
}

struct ScanOps { bf16x8 qa[2][4], ma[2][4]; u32x4 bc[2][2], ou[2][2]; };
DI void scan_load(ScanOps& o, const u16* mb, int r, int h, int nt, int lane) {
#pragma unroll
  for (int mt = 0; mt < 2; ++mt) {
#pragma unroll
    for (int ks = 0; ks < 4; ++ks) {
      o.qa[mt][ks] = *(const bf16x8*)(mb + (32 * mt + r) * 64 + 16 * ks + 8 * h);
      o.ma[mt][ks] = *(const bf16x8*)(mb + 4096 + (32 * mt + r) * 64 + 16 * ks + 8 * h);
    }
    const u16* pb = mb + 2 * 4096 + ((mt * 2 + nt) * 64 + lane) * 16;
    const u16* po = mb + 3 * 4096 + ((mt * 2 + nt) * 64 + lane) * 16;
    o.bc[mt][0] = *(const u32x4*)pb; o.bc[mt][1] = *(const u32x4*)(pb + 8);
    o.ou[mt][0] = *(const u32x4*)po; o.ou[mt][1] = *(const u32x4*)(po + 8);
  }
}
DI f32x16 unpack16v(u32x4 a, u32x4 b) {
  f32x16 v;
  v[0] = bflo(a[0]); v[1] = bfhi(a[0]); v[2] = bflo(a[1]); v[3] = bfhi(a[1]); v[4] = bflo(a[2]); v[5] = bfhi(a[2]); v[6] = bflo(a[3]); v[7] = bfhi(a[3]);
  v[8] = bflo(b[0]); v[9] = bfhi(b[0]); v[10] = bflo(b[1]); v[11] = bfhi(b[1]); v[12] = bflo(b[2]); v[13] = bfhi(b[2]); v[14] = bflo(b[3]); v[15] = bfhi(b[3]);
  return v;
}
DI void scan_step(const ScanOps& o, f32x16 (&S)[2], u16* obuf, size_t rowbase, int ctok, int dir, int colbase, int h) {
  f32x16 ov[2], Sn[2];
#pragma unroll
  for (int mt = 0; mt < 2; ++mt) {
    Sn[mt] = unpack16v(o.bc[mt][0], o.bc[mt][1]);
    ov[mt] = unpack16v(o.ou[mt][0], o.ou[mt][1]);
  }
  bf16x8 Sb[4];
  Sb[0] = pack_frag(S[0], 0); Sb[1] = pack_frag(S[0], 1); Sb[2] = pack_frag(S[1], 0); Sb[3] = pack_frag(S[1], 1);
#pragma unroll
  for (int mt = 0; mt < 2; ++mt)
#pragma unroll
    for (int ks = 0; ks < 4; ++ks) {
      ov[mt] = MFMA32(o.qa[mt][ks], Sb[ks], ov[mt]);
      Sn[mt] = MFMA32(o.ma[mt][ks], Sb[ks], Sn[mt]);
    }
#pragma unroll
  for (int mt = 0; mt < 2; ++mt)
#pragma unroll
    for (int ii = 0; ii < 16; ++ii) {
      int ri = 32 * mt + crow(ii, h);
      int tpos = dir ? (ctok * 64 + 63 - ri) : (ctok * 64 + ri);
      obuf[(rowbase + tpos) * 512 + colbase] = f2bf(ov[mt][ii]);
    }
  S[0] = Sn[0]; S[1] = Sn[1];
}

DI void gdn_scan_item(const Params& P, const Grp& G, int l, int it) {
  const int tid = otid(), lane = tid & 63, w = tid >> 6, r = lane & 31, h = lane >> 5;
  const int head = it & 7, sl = it >> 3;
  const int dir = w >> 1, nt = w & 1;
  const int N = G.nchunk;
  f32x16 S[2];
  if (G.latent) {
    const float* st = P.state_gdn + ((((size_t)(G.seq0 + sl) * 2 + l) * 2 + dir) * 8 + head) * 4096;
#pragma unroll
    for (int mt = 0; mt < 2; ++mt)
#pragma unroll
      for (int ii = 0; ii < 16; ++ii) S[mt][ii] = st[(32 * mt + crow(ii, h)) * 64 + 32 * nt + r];
  } else { S[0] = zero16(); S[1] = zero16(); }
  const u16* base = pGD(P) + ((((size_t)dir * G.nseq + sl) * 8 + head) * N) * 16384;
  u16* obuf = dir ? pOR(P) : pOF(P);
  const size_t rowbase = (size_t)sl * G.seqlen;
  const int colbase = head * 64 + 32 * nt + r;
  ScanOps oa;
  for (int c = 0; c < N; ++c) {
    scan_load(oa, base + (size_t)c * 16384, r, h, nt, lane);
    scan_step(oa, S, obuf, rowbase, dir ? (N - 1 - c) : c, dir, colbase, h);
  }
  if (!G.latent) {
    float* st = P.out + OUT_ST + ((((size_t)sl * 2 + l) * 2 + dir) * 8 + head) * 4096;
#pragma unroll
    for (int mt = 0; mt < 2; ++mt)
#pragma unroll
      for (int ii = 0; ii < 16; ++ii) st[(32 * mt + crow(ii, h)) * 64 + 32 * nt + r] = S[mt][ii];
  }
  __threadfence();
  __syncthreads();
  __threadfence();
  const float* gn = P.gdn_norm_g + l * 64;
#pragma unroll 4
  for (int idx = tid; idx < G.seqlen * 8; idx += 256) {
    int tpos = idx >> 3, part = idx & 7;
    size_t lt = (size_t)sl * G.seqlen + tpos;
    float a[8], b[8], z[8];
    unpack8(*(const uint4*)&pOF(P)[lt * 512 + head * 64 + part * 8], a);
    unpack8(*(const uint4*)&pOR(P)[lt * 512 + head * 64 + part * 8], b);
    u16* zp = &pU(P)[lt * UC + C_Z + head * 64 + part * 8];
    unpack8(*(const uint4*)zp, z);
    float ss = 0.f;
#pragma unroll
    for (int j = 0; j < 8; ++j) { a[j] += b[j]; ss += a[j] * a[j]; }
    ss += __shfl_xor(ss, 1); ss += __shfl_xor(ss, 2); ss += __shfl_xor(ss, 4);
    float rstd = rsqrtf(ss * (1.f / 64.f) + 1e-6f);
#pragma unroll
    for (int j = 0; j < 8; ++j) a[j] = a[j] * rstd * gn[part * 8 + j] * silu_f(z[j]);
    *(uint4*)zp = pack8(a);
  }
  __syncthreads();
}

struct KvRegs { u32x4 k[2], kr, v[2]; };
DI void attn_gload(KvRegs& g, const u16* kvp, const u16* krp, size_t row0, int tid, int head) {
#pragma unroll
  for (int i2 = 0; i2 < 2; ++i2) {
    int c = tid + 256 * i2;
    int key = c >> 3, d8 = (c & 7) * 8;
    const u16* src = &kvp[(row0 + key) * 1024 + head * 128 + d8];
    g.k[i2] = *(const u32x4*)src;
    g.v[i2] = *(const u32x4*)(src + 64);
  }
  g.kr = *(const u32x4*)&krp[(row0 + (tid >> 2)) * 32 + (tid & 3) * 8];
}
DI void attn_lstore(const KvRegs& g, u16* Kl, u16* Vt, int tid) {
#pragma unroll
  for (int i2 = 0; i2 < 2; ++i2) {
    int c = tid + 256 * i2;
    int key = c >> 3, d8 = (c & 7) * 8;
    *(u32x4*)&Kl[key * 104 + d8] = g.k[i2];
    u32x4 vv = g.v[i2];
    u16* vd = &Vt[d8 * 72 + key];
    vd[0] = (u16)(vv[0] & 0xffff); vd[72] = (u16)(vv[0] >> 16); vd[144] = (u16)(vv[1] & 0xffff); vd[216] = (u16)(vv[1] >> 16);
    vd[288] = (u16)(vv[2] & 0xffff); vd[360] = (u16)(vv[2] >> 16); vd[432] = (u16)(vv[3] & 0xffff); vd[504] = (u16)(vv[3] >> 16);
  }
  *(u32x4*)&Kl[(tid >> 2) * 104 + 64 + (tid & 3) * 8] = g.kr;
}
DI void attn_tile(const u16* Kl, const u16* Vt, const bf16x8 (&qf)[6], f32x16 (&O)[2], float& mrun, float& lrun, int r, int h) {
  const float sc = 0.14724455f;
  f32x16 st[2];
#pragma unroll
  for (int mt = 0; mt < 2; ++mt) {
    st[mt] = zero16();
#pragma unroll
    for (int s = 0; s < 6; ++s) st[mt] = MFMA32(*(const bf16x8*)&Kl[(32 * mt + r) * 104 + 16 * s + 8 * h], qf[s], st[mt]);
  }
  float mloc = -1e30f;
#pragma unroll
  for (int mt = 0; mt < 2; ++mt)
#pragma unroll
    for (int ii = 0; ii < 16; ++ii) { st[mt][ii] *= sc; mloc = fmaxf(mloc, st[mt][ii]); }
  mloc = fmaxf(mloc, __shfl_xor(mloc, 32));
  const float mnew = fmaxf(mrun, mloc);
  const float alpha = __builtin_amdgcn_exp2f(mrun - mnew);
  mrun = mnew;
  float ps = 0.f;
#pragma unroll
  for (int mt = 0; mt < 2; ++mt)
#pragma unroll
    for (int ii = 0; ii < 16; ++ii) { float p = __builtin_amdgcn_exp2f(st[mt][ii] - mnew); st[mt][ii] = p; ps += p; }
  lrun = lrun * alpha + ps;
#pragma unroll
  for (int ii = 0; ii < 16; ++ii) { O[0][ii] *= alpha; O[1][ii] *= alpha; }
#pragma unroll
  for (int mt = 0; mt < 2; ++mt)
#pragma unroll
    for (int s2 = 0; s2 < 2; ++s2) {
      bf16x8 pb = pack_frag(st[mt], s2);
#pragma unroll
      for (int dvt = 0; dvt < 2; ++dvt) {
        const u16* vp = &Vt[(32 * dvt + r) * 72 + 32 * mt + 16 * s2 + 4 * h];
        s16x4 lo = *(const s16x4*)vp;
        s16x4 hi = *(const s16x4*)(vp + 8);
        bf16x8 va = __builtin_shufflevector(lo, hi, 0, 1, 2, 3, 4, 5, 6, 7);
        O[dvt] = MFMA32(va, pb, O[dvt]);
      }
    }
}

DI void attn_item(const Params& P, const Grp& G, int it, char* ldsraw) {
  const int tid = otid(), lane = tid & 63, w = tid >> 6, r = lane & 31, h = lane >> 5;
  const int nqb = G.seqlen >> 7;
  const int qb = it % nqb, head = (it / nqb) & 7, sl = it / (nqb * 8);
  u16* Kl0 = (u16*)ldsraw;
  u16* Vt0 = Kl0 + 64 * 104;
  u16* Kl1 = Vt0 + 64 * 72;
  u16* Vt1 = Kl1 + 64 * 104;
  const size_t ltq = (size_t)sl * G.seqlen + qb * 128 + w * 32 + r;
  bf16x8 qf[6];
#pragma unroll
  for (int s = 0; s < 6; ++s) qf[s] = *(const bf16x8*)&pQ(P)[ltq * 768 + head * 96 + s * 16 + h * 8];
  const int nkt = G.kvlen >> 6;
  const size_t kvbase = (size_t)sl * G.kvlen;
  const u16* kvp = pKV(P);
  const u16* krp = pKR(P);
  float mrun = -1e30f, lrun = 0.f;
  f32x16 O[2];
  O[0] = zero16(); O[1] = zero16();
  KvRegs g0, g1;
  attn_gload(g0, kvp, krp, kvbase, tid, head);
  attn_gload(g1, kvp, krp, kvbase + 64, tid, head);
  __syncthreads();
  attn_lstore(g0, Kl0, Vt0, tid);
  __syncthreads();
  for (int kt = 0; kt < nkt; kt += 2) {
    if (kt + 2 < nkt) attn_gload(g0, kvp, krp, kvbase + (size_t)(kt + 2) * 64, tid, head);
    attn_tile(Kl0, Vt0, qf, O, mrun, lrun, r, h);
    attn_lstore(g1, Kl1, Vt1, tid);
    __syncthreads();
    if (kt + 3 < nkt) attn_gload(g1, kvp, krp, kvbase + (size_t)(kt + 3) * 64, tid, head);
    attn_tile(Kl1, Vt1, qf, O, mrun, lrun, r, h);
    if (kt + 2 < nkt) attn_lstore(g0, Kl0, Vt0, tid);
    __syncthreads();
  }
  const float ltot = lrun + __shfl_xor(lrun, 32);
  const float inv = 1.f / ltot;
#pragma unroll
  for (int dvt = 0; dvt < 2; ++dvt)
#pragma unroll
    for (int g4 = 0; g4 < 4; ++g4) {
      u16* gp = &pU(P)[ltq * UC + C_GA + head * 64 + 32 * dvt + 8 * g4 + 4 * h];
      uint2 gw = *(const uint2*)gp;
      float o0 = O[dvt][4 * g4] * inv * silu_f(bflo(gw.x));
      float o1 = O[dvt][4 * g4 + 1] * inv * silu_f(bfhi(gw.x));
      float o2 = O[dvt][4 * g4 + 2] * inv * silu_f(bflo(gw.y));
      float o3 = O[dvt][4 * g4 + 3] * inv * silu_f(bfhi(gw.y));
      *(uint2*)gp = make_uint2(pk2(o0, o1), pk2(o2, o3));
    }
}

DI void convb_item(const Params& P, const Grp& G, int l, int it) {
  const int tid = otid();
  const float* cw = P.conv_b_w + (size_t)l * 3 * 512;
  for (int rep = 0; rep < 16; ++rep) {
    int c = tid + 256 * rep;
    int row = c >> 6, c8 = (c & 63) * 8;
    size_t lt = (size_t)it * 64 + row;
    int tpos = (int)(lt % G.seqlen);
    float cc[8], xx[8], pm[8], p0[8], pp[8], bb[8], gg[8];
    unpack8(*(const uint4*)&pU(P)[lt * UC + C_C + c8], cc);
    unpack8(*(const uint4*)&pU(P)[lt * UC + C_X + c8], xx);
#pragma unroll
    for (int j = 0; j < 8; ++j) p0[j] = cc[j] * xx[j];
    if (tpos > 0) {
      unpack8(*(const uint4*)&pU(P)[(lt - 1) * UC + C_C + c8], cc);
      unpack8(*(const uint4*)&pU(P)[(lt - 1) * UC + C_X + c8], xx);
#pragma unroll
      for (int j = 0; j < 8; ++j) pm[j] = cc[j] * xx[j];
    } else { for (int j = 0; j < 8; ++j) pm[j] = 0.f; }
    if (tpos < G.seqlen - 1) {
      unpack8(*(const uint4*)&pU(P)[(lt + 1) * UC + C_C + c8], cc);
      unpack8(*(const uint4*)&pU(P)[(lt + 1) * UC + C_X + c8], xx);
#pragma unroll
      for (int j = 0; j < 8; ++j) pp[j] = cc[j] * xx[j];
    } else { for (int j = 0; j < 8; ++j) pp[j] = 0.f; }
    unpack8(*(const uint4*)&pU(P)[lt * UC + C_B + c8], bb);
    u16* gp = &pU(P)[lt * UC + C_GB + c8];
    unpack8(*(const uint4*)gp, gg);
    float o[8];
#pragma unroll
    for (int j = 0; j < 8; ++j)
      o[j] = bb[j] * (pm[j] * cw[c8 + j] + p0[j] * cw[512 + c8 + j] + pp[j] * cw[1024 + c8 + j]) * silu_f(gg[j]);
    *(uint4*)gp = pack8(o);
  }
}

DI void merge_tile(const Params& P, int it, char* ldsraw) {
  u16* lds = (u16*)ldsraw;
  const int mtile = (it & 7) * 8 + ((it >> 3) & 7), ntile = it >> 6;
  const int m0 = mtile * 128, n0 = ntile * 128;
  u16* Mb = pKV(P);
  unsigned mp[2][2][8];
#pragma unroll 1
  for (int br = 0; br < 3; ++br) {
    f32x16 acc[2][2];
    acc[0][0] = zero16(); acc[0][1] = zero16(); acc[1][0] = zero16(); acc[1][1] = zero16();
    gemm_mainloop(pH(P) + (size_t)m0 * 1024, 1024, pWT1(P) + (size_t)(C_MG + br * 1024 + n0) * 1024, 1024, 1024, lds, acc);
    unsigned sg[2][2][4];
#pragma unroll
    for (int a2 = 0; a2 < 2; ++a2)
#pragma unroll
      for (int b2 = 0; b2 < 2; ++b2)
#pragma unroll
        for (int i = 0; i < 4; ++i) {
          unsigned q0 = (unsigned)(sigmoid_f(acc[a2][b2][4 * i]) * 255.f + 0.5f), q1 = (unsigned)(sigmoid_f(acc[a2][b2][4 * i + 1]) * 255.f + 0.5f);
          unsigned q2 = (unsigned)(sigmoid_f(acc[a2][b2][4 * i + 2]) * 255.f + 0.5f), q3 = (unsigned)(sigmoid_f(acc[a2][b2][4 * i + 3]) * 255.f + 0.5f);
          sg[a2][b2][i] = q0 | (q1 << 8) | (q2 << 16) | (q3 << 24);
        }
    acc[0][0] = zero16(); acc[0][1] = zero16(); acc[1][0] = zero16(); acc[1][1] = zero16();
    const int ocol = (br == 0) ? C_GA : (br == 1 ? C_GB : C_Z);
    const u16* Wp = (br == 0) ? pWPA(P) : (br == 1 ? pWPB(P) : pWPC(P));
    gemm_mainloop1(pU(P) + (size_t)m0 * UC + ocol, UC, Wp + (size_t)n0 * 512, 512, 512, lds, acc);
#pragma unroll
    for (int a2 = 0; a2 < 2; ++a2)
#pragma unroll
      for (int b2 = 0; b2 < 2; ++b2)
#pragma unroll
        for (int i = 0; i < 4; ++i) {
          const unsigned wq = sg[a2][b2][i];
          acc[a2][b2][4 * i] *= (float)(wq & 255u) * (1.f / 255.f);
          acc[a2][b2][4 * i + 1] *= (float)((wq >> 8) & 255u) * (1.f / 255.f);
          acc[a2][b2][4 * i + 2] *= (float)((wq >> 16) & 255u) * (1.f / 255.f);
          acc[a2][b2][4 * i + 3] *= (float)(wq >> 24) * (1.f / 255.f);
        }
    if (br < 2) {
#pragma unroll
      for (int a2 = 0; a2 < 2; ++a2)
#pragma unroll
        for (int b2 = 0; b2 < 2; ++b2)
#pragma unroll
          for (int i = 0; i < 8; ++i) {
            float lo = acc[a2][b2][2 * i], hi = acc[a2][b2][2 * i + 1];
            if (br > 0) { lo += bflo(mp[a2][b2][i]); hi += bfhi(mp[a2][b2][i]); }
            mp[a2][b2][i] = pk2(lo, hi);
          }
    } else {
#pragma unroll
      for (int a2 = 0; a2 < 2; ++a2)
#pragma unroll
        for (int b2 = 0; b2 < 2; ++b2)
#pragma unroll
          for (int i = 0; i < 8; ++i) { acc[a2][b2][2 * i] += bflo(mp[a2][b2][i]); acc[a2][b2][2 * i + 1] += bfhi(mp[a2][b2][i]); }
      gemm_epilogue(acc, (float*)ldsraw, [&](int row, int col, float* v) {
        *(uint4*)&Mb[(size_t)(m0 + row) * 1024 + n0 + col] = pack8(v);
      });
    }
  }
}

DI void out_tile(const Params& P, const Grp& G, int l, int it, char* ldsraw) {
  u16* lds = (u16*)ldsraw;
  const int mtile = (it & 7) * 8 + ((it >> 3) & 7), ntile = it >> 6;
  const int m0 = mtile * 128, n0 = ntile * 128;
  f32x16 acc[2][2];
  acc[0][0] = zero16(); acc[0][1] = zero16(); acc[1][0] = zero16(); acc[1][1] = zero16();
  gemm_mainloop(pKV(P) + (size_t)m0 * 1024, 1024, pWO(P) + (size_t)n0 * 1024, 1024, 1024, lds, acc);
  gemm_epilogue<4>(acc, (float*)ldsraw, [&](int row, int col, float* v) {
    int lt = m0 + row, n = n0 + col;
    int tok = G.tok0 + lt;
    int cond = G.latent ? 1 + G.seq0 + (lt >> 11) : 0;
    const float* gate = pMOD(P) + (l * 9 + cond) * 3072 + 2048 + n;
    const float* xr = x_row(P, l, tok) + n;
    float4 x0 = *(const float4*)xr, x1 = *(const float4*)(xr + 4);
    float4 g0 = *(const float4*)(gate + 4 * 55296), g1 = *(const float4*)(gate + 4 * 55296 + 4);
    float* dst = P.out + (size_t)tok * 1024 + n;
    *(float4*)dst = make_float4(x0.x + g0.x * v[0], x0.y + g0.y * v[1], x0.z + g0.z * v[2], x0.w + g0.w * v[3]);
    *(float4*)(dst + 4) = make_float4(x1.x + g1.x * v[4], x1.y + g1.y * v[5], x1.z + g1.z * v[6], x1.w + g1.w * v[7]);
  });
}

DI void final_norm_phase(const Params& P) {
  int wave = (blockIdx.x * 256 + otid()) >> 6, lane = otid() & 63, nw = gridDim.x * 4;
  for (int r = wave; r < 24576; r += nw) {
    float* xr = P.out + (size_t)r * 1024;
    float4 v[4];
    float ss = 0.f;
#pragma unroll
    for (int i = 0; i < 4; ++i) {
      v[i] = *(const float4*)(xr + i * 256 + lane * 4);
      ss += v[i].x * v[i].x + v[i].y * v[i].y + v[i].z * v[i].z + v[i].w * v[i].w;
    }
    ss = wave_sum(ss);
    float rstd = rsqrtf(ss * (1.f / 1024.f) + 1e-6f);
#pragma unroll
    for (int i = 0; i < 4; ++i) {
      int col = i * 256 + lane * 4;
      float4 gg = *(const float4*)(P.final_norm_g + col);
      *(float4*)(xr + col) = make_float4(v[i].x * rstd * gg.x, v[i].y * rstd * gg.y, v[i].z * rstd * gg.z, v[i].w * rstd * gg.w);
    }
  }
}

#define XB_TMO      128
#define XB_XCNT(j)  (256  + 64 * (j))
#define XB_XSUB(j)  (1280 + 64 * (j))
#define XB_XGEN(j)  (2304 + 64 * (j))
#define XB_TOP      3328
#define XB_TOPGEN   3392
#define XCD_BAR_WORDS 3456
#define XB_SPIN_CAP (1u << 18)
#define LAS __attribute__((address_space(3)))

__device__ __forceinline__ unsigned xb_ld(unsigned* p)              { return __hip_atomic_load(p, __ATOMIC_RELAXED, __HIP_MEMORY_SCOPE_AGENT); }
__device__ __forceinline__ unsigned xb_add(unsigned* p, unsigned v) { return __hip_atomic_fetch_add(p, v, __ATOMIC_RELAXED, __HIP_MEMORY_SCOPE_AGENT); }
__device__ __forceinline__ unsigned xb_xcc_id() { return (unsigned)__builtin_amdgcn_s_getreg((3 << 11) | 20) & 0xFu; }
#define XB_SPIN(cond, bar) do { unsigned _sp = 0; while (cond) { __builtin_amdgcn_s_sleep(1); \
    if ((++_sp & 255u) == 0u) { if (xb_ld(&(bar)[XB_TMO])) break; if (_sp > XB_SPIN_CAP) { atomicAdd(&(bar)[XB_TMO], 1u); break; } } } } while (0)

struct XcdBarrier {
    unsigned* bar; unsigned x;
    volatile LAS unsigned* st;
};

__device__ __forceinline__ XcdBarrier xcd_barrier_post(unsigned* bar, volatile LAS unsigned* st) {
    XcdBarrier b; b.bar = bar; b.x = xb_xcc_id(); b.st = st;
    if (threadIdx.x == 0) (void)xb_add(&bar[XB_XCNT(b.x)], 1u);
    return b;
}
__device__ __forceinline__ void xcd_barrier_complete(unsigned* bar, unsigned x, unsigned& nloc, unsigned& nx) {
    const unsigned G = gridDim.x * gridDim.y * gridDim.z;
    unsigned sum, cnt, mine, sp = 0u;
    for (;;) {
        sum = 0u; cnt = 0u; mine = 0u;
#pragma unroll
        for (unsigned j = 0; j < 16; ++j) { const unsigned c = xb_ld(&bar[XB_XCNT(j)]); sum += c; cnt += (c > 0u) ? 1u : 0u; mine = (j == x) ? c : mine; }
        if (sum == G) break;
        __builtin_amdgcn_s_sleep(1);
        if ((++sp & 255u) == 0u) { if (xb_ld(&bar[XB_TMO])) break; if (sp > XB_SPIN_CAP) { atomicAdd(&bar[XB_TMO], 1u); break; } }
    }
    nloc = mine > 0u ? mine : 1u; nx = cnt > 0u ? cnt : 1u;
}

__device__ __forceinline__ void xcd_barrier(const XcdBarrier& b) {
    asm volatile("s_waitcnt vmcnt(0)" ::: "memory");
    __syncthreads();
    if (threadIdx.x == 0) {
        unsigned* bar = b.bar;
        __builtin_amdgcn_s_waitcnt(0);
        unsigned nloc = b.st[0], nx = b.st[1];
        if (nloc == 0u) { xcd_barrier_complete(bar, b.x, nloc, nx); b.st[0] = nloc; b.st[1] = nx; }
        const unsigned old = xb_add(&bar[XB_XSUB(b.x)], 1u);
        const unsigned gen = old / nloc;
        if (old + 1u == (gen + 1u) * nloc) {
            __builtin_amdgcn_fence(__ATOMIC_RELEASE, "agent");
            asm volatile("s_waitcnt vmcnt(0)" ::: "memory");
            const unsigned og = xb_add(&bar[XB_TOP], 1u);
            const unsigned tg = og / nx;
            if (og + 1u == (tg + 1u) * nx) xb_add(&bar[XB_TOPGEN], 1u);
            else XB_SPIN(xb_ld(&bar[XB_TOPGEN]) == tg, bar);
            __builtin_amdgcn_fence(__ATOMIC_ACQUIRE, "agent");
            xb_add(&bar[XB_XGEN(b.x)], 1u);
            asm volatile("s_waitcnt vmcnt(0)" ::: "memory");
        } else {
            XB_SPIN(xb_ld(&bar[XB_XGEN(b.x)]) == gen, bar);
            __builtin_amdgcn_fence(__ATOMIC_ACQUIRE, "agent");
            asm volatile("s_waitcnt vmcnt(0)" ::: "memory");
        }
    }
    __syncthreads();
}

#ifndef PROBE
#define PROBE 0
#endif
#define GSYNC() do { xcd_barrier(xb); if (PROBE & 1) xcd_barrier(xb); } while (0)
__global__ void __launch_bounds__(256, 2) mega(Params P) {
  cg::grid_group grid = cg::this_grid();
  __shared__ __attribute__((aligned(16))) char lds[LDS_TOTAL];
  __shared__ __attribute__((aligned(16))) unsigned xb_words[4];
  __shared__ int s_item;
  if (threadIdx.x < 4) xb_words[threadIdx.x] = 0u;
  __syncthreads();
  const XcdBarrier xb = xcd_barrier_post((unsigned*)(P.ws + O_BAR), (volatile LAS unsigned*)xb_words);
  if (P.out == nullptr) grid.sync();
  for (int it = blockIdx.x; it < 384; it += gridDim.x) mod_item(P, it, (float*)lds);
  convert_phase(P, 0, (float*)lds);
  GSYNC();
  norm_phase(P, make_grp(0), 0, true);
  GSYNC();
  for (int l = 0; l < 2; ++l) {
    if (l == 1) { convert_phase(P, 1, (float*)lds); norm_phase(P, make_grp(0), 1); GSYNC(); }
    for (int g = 0; g < 3; ++g) {
      const Grp G = make_grp(g);
      if (l == 0 && g == 0) {
        float* md = pMOD(P);
        for (int i = blockIdx.x * 256 + threadIdx.x; i < 55296; i += gridDim.x * 256)
          md[4 * 55296 + i] = md[i] + md[55296 + i] + md[2 * 55296 + i] + md[3 * 55296 + i];
      }
      for (int rep = 0; rep < ((PROBE & 2) ? 2 : 1); ++rep) gemm1_phase(P, G, l, lds);
      GSYNC();
      for (int rep = 0; rep < ((PROBE & 4) ? 2 : 1); ++rep) {
        const int nq = 64 * 6, nkv = (G.latent ? 72 : 64) * 8, ngd = 128 * 8, nx = 128;
        for (int it = blockIdx.x; it < nq + nkv + ngd + nx; it += gridDim.x) {
          if (it < ngd) gdn_prep_item(P, G, l, it, lds);
          else if (it < ngd + nx) { const int e = it - ngd; gemm1_tile(P, G, l, e >> 1, 6 + (e & 1), lds); }
          else if (it < ngd + nx + nkv) kvexp_tile(P, G, l, it - ngd - nx, lds);
          else qproj_tile(P, G, it - ngd - nx - nkv, lds);
        }
      }
      GSYNC();
      {
        const int nsc = G.nseq * 8, nat = 512, ncv = 128;
        unsigned* ctr = (unsigned*)(P.ws + O_BAR) + (l * 3 + g);
        for (;;) {
          __syncthreads();
          if (threadIdx.x == 0) s_item = (int)atomicAdd(ctr, 1u);
          __syncthreads();
          const int it = s_item;
          if (it >= nsc + nat + ncv) break;
          if (it < nsc) gdn_scan_item(P, G, l, it);
          else if (it < nsc + nat) attn_item(P, G, it - nsc, lds);
          else convb_item(P, G, l, it - nsc - nat);
        }
      }
      GSYNC();
      stagger();
      for (int rep = 0; rep < ((PROBE & 8) ? 2 : 1); ++rep)
        for (int it = blockIdx.x; it < 512; it += gridDim.x) merge_tile(P, it, lds);
      GSYNC();
      for (int it = blockIdx.x; it < 512; it += gridDim.x) out_tile(P, G, l, it, lds);
      if (g < 2) norm_phase(P, make_grp(g + 1), l);
      GSYNC();
    }
  }
  final_norm_phase(P);
}

extern "C" void kernel_launch(void* const* d_in, const int* in_sizes, int n_in, void* d_out, int out_size,
                              void* d_ws, size_t ws_size, hipStream_t stream) {
  static int grid_blocks = 0;
  if (!grid_blocks) {
    int dev = 0, cus = 0, per_cu = 0;
    hipGetDevice(&dev);
    hipDeviceGetAttribute(&cus, hipDeviceAttributeMultiprocessorCount, dev);
    hipOccupancyMaxActiveBlocksPerMultiprocessor(&per_cu, mega, 256, 0);
    if (per_cu > 2) per_cu = 2;
    if (per_cu < 1) per_cu = 1;
    grid_blocks = cus * per_cu;
  }
  Params p{};
  const float** pin = (const float**)&p;
  for (int i = 0; i < 25; ++i) pin[i] = (const float*)d_in[i];
  p.out = (float*)d_out;
  p.ws = (char*)d_ws;
  if (WS_NEED > ws_size) { fprintf(stderr, "workspace too small: need %zu have %zu\n", (size_t)WS_NEED, ws_size); return; }
  (void)hipMemsetAsync((char*)d_ws + O_BAR, 0, 16384, stream);
  void* args[] = {&p};
  hipError_t e = hipLaunchCooperativeKernel((void*)mega, dim3(grid_blocks), dim3(256), args, 0, stream);
  if (e != hipSuccess) fprintf(stderr, "cooperative launch failed: %s (grid %d)\n", hipGetErrorString(e), grid_blocks);
}
```

```cpp
#include <hip/hip_runtime.h>
#include <hip/hip_cooperative_groups.h>
#include <cstdio>
namespace cg = cooperative_groups;

typedef unsigned short u16;
typedef __attribute__((ext_vector_type(8))) short bf16x8;
typedef __attribute__((ext_vector_type(4))) short s16x4;
typedef __attribute__((ext_vector_type(16))) float f32x16;
typedef __attribute__((ext_vector_type(2))) __bf16 bf2_t;
typedef __attribute__((ext_vector_type(4))) unsigned u32x4;

#define DI __device__ __forceinline__
#define MFMA32(a, b, c) __builtin_amdgcn_mfma_f32_32x32x16_bf16((a), (b), (c), 0, 0, 0)

constexpr int D = 1024;
constexpr int DIN = 8384;
constexpr int UC = 5312;
constexpr int TG = 8192;
constexpr int KVROWS = 9216;
constexpr int C_CQ = 0, C_CKV = 384, C_KPE = 640, C_GA = 672, C_B = 1184, C_C = 1696, C_X = 2208, C_GB = 2720,
              C_Q = 3232, C_K = 3744, C_V = 4256, C_Z = 4768, C_AB = 5280, C_MG = 5312;
constexpr int LDS_MAIN = 73728;
constexpr int LDS_TOTAL = LDS_MAIN + 4096;
constexpr size_t OUT_CKV = 25165824, OUT_KPE = 29360128, OUT_ST = 29884416;

struct Params {
  const float *x_prompt, *x_sample, *c, *cache_ckv, *cache_kpe, *state_gdn, *c_ctx, *norm_g, *w_ada, *b_ada, *w_in,
      *q_norm_g, *kv_norm_g, *w_uq, *w_ukv, *conv_b_w, *conv_qkv_w, *a_log, *dt_bias, *gdn_norm_g, *w_pa, *w_pb, *w_pc,
      *w_o, *final_norm_g;
  float* out;
  char* ws;
};
constexpr size_t al256(size_t x) { return (x + 255) & ~(size_t)255; }
constexpr size_t O_WT1 = 0;
constexpr size_t O_WUQ = O_WT1 + al256((size_t)DIN * 1024 * 2);
constexpr size_t O_WUKVF = O_WUQ + al256((size_t)768 * 384 * 2);
constexpr size_t O_WUKV = O_WUKVF + al256((size_t)1024 * 256 * 2);
constexpr size_t O_WPA = O_WUKV + al256((size_t)1024 * 256 * 2);
constexpr size_t O_WPB = O_WPA + al256((size_t)1024 * 512 * 2);
constexpr size_t O_WPC = O_WPB + al256((size_t)1024 * 512 * 2);
constexpr size_t O_WO = O_WPC + al256((size_t)1024 * 512 * 2);
constexpr size_t O_MOD = O_WO + al256((size_t)1024 * 1024 * 2);
constexpr size_t O_H = O_MOD + al256((size_t)5 * 2 * 9 * 3072 * 4);
constexpr size_t O_U = O_H + al256((size_t)TG * 1024 * 2);
constexpr size_t O_GAB = O_U + al256((size_t)TG * UC * 2);
constexpr size_t O_Q = O_GAB + al256((size_t)TG * 32 * 4);
constexpr size_t O_KV = O_Q + al256((size_t)TG * 768 * 2);
constexpr size_t O_KR = O_KV + al256((size_t)KVROWS * 1024 * 2);
constexpr size_t O_CKVC = O_KR + al256((size_t)KVROWS * 32 * 2);
constexpr size_t O_GD = O_CKVC + al256((size_t)1024 * 256 * 2);
constexpr size_t O_OF = O_GD + al256((size_t)2 * 128 * 8 * 16384 * 2);
constexpr size_t O_OR = O_OF + al256((size_t)TG * 512 * 2);
constexpr size_t O_BAR = O_OR + al256((size_t)TG * 512 * 2);
constexpr size_t WS_NEED = O_BAR + 16384;
#define WSP(T, name, off) DI T* name(const Params& P) { return (T*)(P.ws + (off)); }
WSP(u16, pWT1, O_WT1) WSP(u16, pWUQ, O_WUQ) WSP(u16, pWUKVF, O_WUKVF) WSP(u16, pWUKV, O_WUKV) WSP(u16, pWPA, O_WPA)
WSP(u16, pWPB, O_WPB) WSP(u16, pWPC, O_WPC) WSP(u16, pWO, O_WO) WSP(float, pMOD, O_MOD) WSP(u16, pH, O_H) WSP(u16, pU, O_U)
WSP(float, pGAB, O_GAB) WSP(u16, pQ, O_Q) WSP(u16, pKV, O_KV) WSP(u16, pKR, O_KR) WSP(u16, pCKVC, O_CKVC) WSP(u16, pGD, O_GD)
WSP(u16, pOF, O_OF) WSP(u16, pOR, O_OR) WSP(float, pMF, O_GD)

struct Grp { int tok0, nseq, seqlen, latent, seq0, nchunk, kvlen; };
DI Grp make_grp(int g) {
  Grp r;
  if (g == 0) { r.tok0 = 0; r.nseq = 32; r.seqlen = 256; r.latent = 0; r.seq0 = 0; r.kvlen = 256; }
  else { r.tok0 = 8192 * g; r.nseq = 4; r.seqlen = 2048; r.latent = 1; r.seq0 = (g - 1) * 4; r.kvlen = 2304; }
  r.nchunk = r.seqlen / 64;
  return r;
}

DI int otid() { int t = __builtin_amdgcn_workitem_id_x(); asm volatile("" : "+v"(t)); return t; }
DI unsigned pk2(float a, float b) { bf2_t v; v[0] = (__bf16)a; v[1] = (__bf16)b; return __builtin_bit_cast(unsigned, v); }
DI u16 f2bf(float a) { return __builtin_bit_cast(u16, (__bf16)a); }
DI float bf2f(u16 x) { return __uint_as_float(((unsigned)x) << 16); }
DI float bflo(unsigned w) { return __uint_as_float(w << 16); }
DI float bfhi(unsigned w) { return __uint_as_float(w & 0xffff0000u); }
DI void unpack8(uint4 w, float* v) {
  v[0] = bflo(w.x); v[1] = bfhi(w.x); v[2] = bflo(w.y); v[3] = bfhi(w.y);
  v[4] = bflo(w.z); v[5] = bfhi(w.z); v[6] = bflo(w.w); v[7] = bfhi(w.w);
}
DI uint4 pack8(const float* v) { return make_uint4(pk2(v[0], v[1]), pk2(v[2], v[3]), pk2(v[4], v[5]), pk2(v[6], v[7])); }
DI float silu_f(float x) { return x / (1.f + __expf(-x)); }
DI float sigmoid_f(float x) { return 1.f / (1.f + __expf(-x)); }
DI int crow(int i, int h) { return (i & 3) + 8 * (i >> 2) + 4 * h; }
DI int swap23(int k) { return (k & ~12) | ((k & 4) << 1) | ((k & 8) >> 1); }
DI float wave_sum(float v) {
  v += __shfl_xor(v, 32); v += __shfl_xor(v, 16); v += __shfl_xor(v, 8);
  v += __shfl_xor(v, 4); v += __shfl_xor(v, 2); v += __shfl_xor(v, 1);
  return v;
}
DI bf16x8 pack_frag(const f32x16& x, int s) {
  uint4 p = make_uint4(pk2(x[8 * s], x[8 * s + 1]), pk2(x[8 * s + 2], x[8 * s + 3]), pk2(x[8 * s + 4], x[8 * s + 5]),
                       pk2(x[8 * s + 6], x[8 * s + 7]));
  return __builtin_bit_cast(bf16x8, p);
}
DI f32x16 zero16() { f32x16 z; for (int i = 0; i < 16; ++i) z[i] = 0.f; return z; }
DI void rope8(float* v, int pi0, int tpos) {
#pragma unroll
  for (int j = 0; j < 4; ++j) {
    int pi = pi0 + j;
    int f = pi & 7;
    float pos = (float)((pi < 8) ? (tpos >> 6) : (tpos & 63));
    float ang = pos * __builtin_amdgcn_exp2f(-(float)f * 1.6609640474436813f);
    float cs = __cosf(ang), sn = __sinf(ang);
    float x0 = v[2 * j], x1 = v[2 * j + 1];
    v[2 * j] = x0 * cs - x1 * sn;
    v[2 * j + 1] = x0 * sn + x1 * cs;
  }
}

DI void mod_item(const Params& P, int it, float* lds) {
  const int kq4 = it & 3, cg = (it >> 2) % 48, l = it / 192;
  const int c0 = cg * 64;
  int tid = otid();
  float* sc = lds;
  for (int i = tid; i < 9 * 256; i += 256) {
    int b = i >> 8, k = kq4 * 256 + (i & 255);
    float cv = (b == 0) ? P.c_ctx[k] : P.c[(b - 1) * 1024 + k];
    sc[i] = silu_f(cv);
  }
  __syncthreads();
  int col = tid & 63, kq = tid >> 6;
  float acc[9];
#pragma unroll
  for (int b = 0; b < 9; ++b) acc[b] = 0.f;
  const float* w = P.w_ada + (size_t)l * 1024 * 3072 + (size_t)(kq4 * 256 + kq * 64) * 3072 + c0 + col;
#pragma unroll 8
  for (int k = 0; k < 64; ++k) {
    float wv = w[(size_t)k * 3072];
#pragma unroll
    for (int b = 0; b < 9; ++b) acc[b] += sc[b * 256 + kq * 64 + k] * wv;
  }
  float* red = lds + 9 * 256;
#pragma unroll
  for (int b = 0; b < 9; ++b) red[(kq * 9 + b) * 64 + col] = acc[b];
  __syncthreads();
  for (int i = tid; i < 9 * 64; i += 256) {
    int b = i >> 6, cc = i & 63;
    float s = red[(0 * 9 + b) * 64 + cc] + red[(1 * 9 + b) * 64 + cc] + red[(2 * 9 + b) * 64 + cc] + red[(3 * 9 + b) * 64 + cc];
    if (kq4 == 0) s += P.b_ada[l * 3072 + c0 + cc];
    pMOD(P)[(size_t)kq4 * 55296 + (l * 9 + b) * 3072 + c0 + cc] = s;
  }
  __syncthreads();
}
DI float4 mod4(const float* p) {
  float4 a = *(const float4*)p, b = *(const float4*)(p + 55296), c = *(const float4*)(p + 2 * 55296), d = *(const float4*)(p + 3 * 55296);
  return make_float4(a.x + b.x + c.x + d.x, a.y + b.y + c.y + d.y, a.z + b.z + c.z + d.z, a.w + b.w + c.w + d.w);
}

DI void convT_tile(const float* __restrict__ src, int K, int N, u16* __restrict__ dst, const float* __restrict__ g, int tk, int tn, float* lds) {
  int tid = otid();
  int k0 = tk * 64, n0 = tn * 64;
  for (int i = tid; i < 4096; i += 256) {
    int kk = i >> 6, nn = i & 63;
    float v = src[(size_t)(k0 + kk) * N + n0 + nn];
    if (g) v *= g[k0 + kk];
    lds[kk * 65 + nn] = v;
  }
  __syncthreads();
  for (int i = tid; i < 512; i += 256) {
    int nn = i >> 3, kc = (i & 7) * 8;
    float v[8];
#pragma unroll
    for (int j = 0; j < 8; ++j) v[j] = lds[(kc + j) * 65 + nn];
    *(uint4*)&dst[(size_t)(n0 + nn) * K + k0 + kc] = pack8(v);
  }
  __syncthreads();
}

DI void convert_phase(const Params& P, int l, float* lds) {
  for (int it = blockIdx.x; it < 2936; it += gridDim.x) {
    int i = it;
    if (i < 2096) { convT_tile(P.w_in + (size_t)l * 1024 * DIN, 1024, DIN, pWT1(P), nullptr, i % 16, i / 16, lds); continue; }
    i -= 2096;
    if (i < 72) { convT_tile(P.w_uq + (size_t)l * 384 * 768, 384, 768, pWUQ(P), P.q_norm_g + l * 384, i % 6, i / 6, lds); continue; }
    i -= 72;
    if (i < 64) { convT_tile(P.w_ukv + (size_t)l * 256 * 1024, 256, 1024, pWUKVF(P), P.kv_norm_g + l * 256, i % 4, i / 4, lds); continue; }
    i -= 64;
    if (i < 64) { convT_tile(P.w_ukv + (size_t)l * 256 * 1024, 256, 1024, pWUKV(P), nullptr, i % 4, i / 4, lds); continue; }
    i -= 64;
    if (i < 128) { convT_tile(P.w_pa + (size_t)l * 512 * 1024, 512, 1024, pWPA(P), nullptr, i % 8, i / 8, lds); continue; }
    i -= 128;
    if (i < 128) { convT_tile(P.w_pb + (size_t)l * 512 * 1024, 512, 1024, pWPB(P), nullptr, i % 8, i / 8, lds); continue; }
    i -= 128;
    if (i < 128) { convT_tile(P.w_pc + (size_t)l * 512 * 1024, 512, 1024, pWPC(P), nullptr, i % 8, i / 8, lds); continue; }
    i -= 128;
    convT_tile(P.w_o + (size_t)l * 1024 * 1024, 1024, 1024, pWO(P), nullptr, i % 16, i / 16, lds);
  }
}

DI const float* x_row(const Params& P, int l, int tok) {
  if (l == 0) return (tok < 8192) ? P.x_prompt + (size_t)tok * 1024 : P.x_sample + (size_t)(tok - 8192) * 1024;
  return P.out + (size_t)tok * 1024;
}
DI void norm_phase(const Params& P, const Grp& G, int l, bool first = false) {
  int wave = (blockIdx.x * 256 + otid()) >> 6, lane = otid() & 63, nw = gridDim.x * 4;
  const float* ng = P.norm_g + l * 1024;
  for (int r = wave; r < TG; r += nw) {
    int tok = G.tok0 + r;
    const float* xr = x_row(P, l, tok);
    int cond = G.latent ? 1 + G.seq0 + (r >> 11) : 0;
    const float* mod = pMOD(P) + (l * 9 + cond) * 3072;
    float4 v[4];
    float ss = 0.f;
#pragma unroll
    for (int i = 0; i < 4; ++i) {
      v[i] = *(const float4*)(xr + i * 256 + lane * 4);
      ss += v[i].x * v[i].x + v[i].y * v[i].y + v[i].z * v[i].z + v[i].w * v[i].w;
    }
    ss = wave_sum(ss);
    float rstd = rsqrtf(ss * (1.f / 1024.f) + 1e-6f);
#pragma unroll
    for (int i = 0; i < 4; ++i) {
      int col = i * 256 + lane * 4;
      float4 gg = *(const float4*)(ng + col);
      float4 sh = first ? mod4(mod + col) : *(const float4*)(mod + 4 * 55296 + col);
      float4 scl = first ? mod4(mod + 1024 + col) : *(const float4*)(mod + 4 * 55296 + 1024 + col);
      float h0 = v[i].x * rstd * gg.x * (1.f + scl.x) + sh.x;
      float h1 = v[i].y * rstd * gg.y * (1.f + scl.y) + sh.y;
      float h2 = v[i].z * rstd * gg.z * (1.f + scl.z) + sh.z;
      float h3 = v[i].w * rstd * gg.w * (1.f + scl.w) + sh.w;
      *(uint2*)&pH(P)[(size_t)r * 1024 + col] = make_uint2(pk2(h0, h1), pk2(h2, h3));
    }
  }
  if (G.latent) {
    int gt = blockIdx.x * 256 + otid(), nth = gridDim.x * 256;
    for (int i = gt; i < 1024 * 256; i += nth) {
      int row = i >> 8, cc = i & 255;
      int sl = row >> 8, p = row & 255;
      pCKVC(P)[i] = f2bf(P.cache_ckv[(((size_t)(G.seq0 + sl) * 2 + l) * 256 + p) * 256 + cc]);
    }
    for (int i = gt; i < 1024 * 32; i += nth) {
      int row = i >> 5, cc = i & 31;
      int sl = row >> 8, p = row & 255;
      pKR(P)[((size_t)sl * 2304 + p) * 32 + cc] = f2bf(P.cache_kpe[(((size_t)(G.seq0 + sl) * 2 + l) * 256 + p) * 32 + cc]);
    }
  }
}

DI void g_load(u32x4 (&ra)[4], u32x4 (&rb)[4], const u16* ga, const u16* gb, size_t sa32, size_t sb32, int kt) {
#pragma unroll
  for (int i = 0; i < 4; ++i) {
    ra[i] = *(const u32x4*)(ga + i * sa32 + kt * 64);
    rb[i] = *(const u32x4*)(gb + i * sb32 + kt * 64);
  }
}
DI void l_store(const u32x4 (&ra)[4], const u32x4 (&rb)[4], u16* dA, u16* dB, int lrow, int lcol) {
#pragma unroll
  for (int i = 0; i < 4; ++i) {
    *(u32x4*)&dA[(lrow + 32 * i) * 72 + lcol] = ra[i];
    *(u32x4*)&dB[(lrow + 32 * i) * 72 + lcol] = rb[i];
  }
}
DI void t_compute(const u16* cA, const u16* cB, f32x16 (&acc)[2][2]) {
#pragma unroll
  for (int s = 0; s < 4; ++s) {
    bf16x8 a0 = *(const bf16x8*)(cA + s * 16);
    bf16x8 a1 = *(const bf16x8*)(cA + 32 * 72 + s * 16);
    bf16x8 b0 = *(const bf16x8*)(cB + s * 16);
    bf16x8 b1 = *(const bf16x8*)(cB + 32 * 72 + s * 16);
    acc[0][0] = MFMA32(a0, b0, acc[0][0]);
    acc[0][1] = MFMA32(a0, b1, acc[0][1]);
    acc[1][0] = MFMA32(a1, b0, acc[1][0]);
    acc[1][1] = MFMA32(a1, b1, acc[1][1]);
  }
}
DI void gemm_mainloop(const u16* __restrict__ A, int lda, const u16* __restrict__ B, int ldb, int K, u16* lds, f32x16 (&acc)[2][2]) {
  const int tid = otid(), lane = tid & 63, w = tid >> 6, wr = w >> 1, wc = w & 1, r = lane & 31, h = lane >> 5;
  u16* sA = lds;
  u16* sB = lds + 2 * 128 * 72;
  const int lrow = tid >> 3, lcol = (tid & 7) * 8;
  const u16* ga = A + (size_t)lrow * lda + lcol;
  const u16* gb = B + (size_t)lrow * ldb + lcol;
  const size_t sa32 = (size_t)32 * lda, sb32 = (size_t)32 * ldb;
  u32x4 ra0[4], rb0[4], ra1[4], rb1[4];
  const int nk = K >> 6;
  const u16* cA = sA + (wr * 64 + r) * 72 + h * 8;
  const u16* cB = sB + (wc * 64 + r) * 72 + h * 8;
  g_load(ra0, rb0, ga, gb, sa32, sb32, 0);
  g_load(ra1, rb1, ga, gb, sa32, sb32, 1);
  l_store(ra0, rb0, sA, sB, lrow, lcol);
  __syncthreads();
  for (int kt = 0; kt < nk; kt += 2) {
    if (kt + 2 < nk) g_load(ra0, rb0, ga, gb, sa32, sb32, kt + 2);
    t_compute(cA, cB, acc);
    l_store(ra1, rb1, sA + 128 * 72, sB + 128 * 72, lrow, lcol);
    __syncthreads();
    if (kt + 3 < nk) g_load(ra1, rb1, ga, gb, sa32, sb32, kt + 3);
    t_compute(cA + 128 * 72, cB + 128 * 72, acc);
    if (kt + 2 < nk) l_store(ra0, rb0, sA, sB, lrow, lcol);
    __syncthreads();
  }
}

DI void gemm_mainloop1(const u16* __restrict__ A, int lda, const u16* __restrict__ B, int ldb, int K, u16* lds, f32x16 (&acc)[2][2]) {
  const int tid = otid(), lane = tid & 63, w = tid >> 6, wr = w >> 1, wc = w & 1, r = lane & 31, h = lane >> 5;
  u16* sA = lds;
  u16* sB = lds + 2 * 128 * 72;
  const int lrow = tid >> 3, lcol = (tid & 7) * 8;
  const u16* ga = A + (size_t)lrow * lda + lcol;
  const u16* gb = B + (size_t)lrow * ldb + lcol;
  const size_t sa32 = (size_t)32 * lda, sb32 = (size_t)32 * ldb;
  u32x4 ra[4], rb[4];
  const int nk = K >> 6;
  const u16* cA = sA + (wr * 64 + r) * 72 + h * 8;
  const u16* cB = sB + (wc * 64 + r) * 72 + h * 8;
  g_load(ra, rb, ga, gb, sa32, sb32, 0);
  l_store(ra, rb, sA, sB, lrow, lcol);
  __syncthreads();
  for (int kt = 0; kt < nk; ++kt) {
    const int cur = kt & 1;
    if (kt + 1 < nk) g_load(ra, rb, ga, gb, sa32, sb32, kt + 1);
    t_compute(cA + cur * 128 * 72, cB + cur * 128 * 72, acc);
    if (kt + 1 < nk) l_store(ra, rb, sA + (cur ^ 1) * 128 * 72, sB + (cur ^ 1) * 128 * 72, lrow, lcol);
    __syncthreads();
  }
}

template <int UNR = 2, class F>
DI void gemm_epilogue(f32x16 (&acc)[2][2], float* cs, F f) {
  const int tid = otid(), lane = tid & 63, w = tid >> 6, wr = w >> 1, wc = w & 1, r = lane & 31, h = lane >> 5;
#pragma unroll
  for (int mt = 0; mt < 2; ++mt)
#pragma unroll
    for (int nt = 0; nt < 2; ++nt)
#pragma unroll
      for (int i = 0; i < 16; ++i) cs[(wr * 64 + mt * 32 + crow(i, h)) * 132 + wc * 64 + nt * 32 + r] = acc[mt][nt][i];
  __syncthreads();
#pragma unroll UNR
  for (int it = 0; it < 8; ++it) {
    int c = tid + 256 * it;
    int row = c >> 4, col = (c & 15) * 8;
    float v[8];
    float4 a = *(const float4*)&cs[row * 132 + col];
    float4 b = *(const float4*)&cs[row * 132 + col + 4];
    v[0] = a.x; v[1] = a.y; v[2] = a.z; v[3] = a.w; v[4] = b.x; v[5] = b.y; v[6] = b.z; v[7] = b.w;
    f(row, col, v);
  }
  __syncthreads();
}

DI void stagger() { if (blockIdx.x >= (gridDim.x >> 1)) __builtin_amdgcn_s_sleep(24); }
DI void gemm1_tile(const Params& P, const Grp& G, int l, int mtile, int ntile, char* ldsraw) {
  u16* lds = (u16*)ldsraw;
  {
    const int m0 = mtile * 128, n0 = ntile * 128;
    f32x16 acc[2][2];
    acc[0][0] = zero16(); acc[0][1] = zero16(); acc[1][0] = zero16(); acc[1][1] = zero16();
    gemm_mainloop(pH(P) + (size_t)m0 * 1024, 1024, pWT1(P) + (size_t)n0 * 1024, 1024, 1024, lds, acc);
    gemm_epilogue(acc, (float*)ldsraw, [&](int row, int col, float* v) {
      int n = n0 + col;
      if (n >= UC) return;
      int lt = m0 + row;
      *(uint4*)&pU(P)[(size_t)lt * UC + n] = pack8(v);
      if (n >= C_KPE && n < C_KPE + 32) {
        int cc = n - C_KPE;
        int sl = lt / G.seqlen, tpos = lt % G.seqlen;
        if (!G.latent) {
          float* dst = P.out + OUT_KPE + (((size_t)sl * 2 + l) * 256 + tpos) * 32 + cc;
          *(float4*)dst = make_float4(v[0], v[1], v[2], v[3]);
          *(float4*)(dst + 4) = make_float4(v[4], v[5], v[6], v[7]);
          *(uint4*)&pKR(P)[(size_t)lt * 32 + cc] = pack8(v);
        } else {
          rope8(v, cc >> 1, tpos);
          *(uint4*)&pKR(P)[((size_t)sl * 2304 + 256 + tpos) * 32 + cc] = pack8(v);
        }
      } else if (n >= C_AB) {
        float* dst = pGAB(P) + (size_t)lt * 32 + (n - C_AB);
        *(float4*)dst = make_float4(v[0], v[1], v[2], v[3]);
        *(float4*)(dst + 4) = make_float4(v[4], v[5], v[6], v[7]);
      }
    });
  }
}
DI void gemm1_phase(const Params& P, const Grp& G, int l, char* ldsraw) {
  for (int it = blockIdx.x; it < 64 * 40; it += gridDim.x) {
    int xcd = it & 7, j = it >> 3;
    int sj = j / 40, q = j % 40;
    int S = xcd + 8 * sj;
    int mtile = (S & 7) * 8 + (q & 7), nidx = (S >> 3) * 5 + (q >> 3);
    gemm1_tile(P, G, l, mtile, nidx < 6 ? nidx : nidx + 2, ldsraw);
  }
}

DI void rowstat(const u16* __restrict__ A, int lda, int K, float* rs) {
  int tid = otid();
  int row = tid >> 1, half = tid & 1;
  const u16* p = A + (size_t)row * lda + half * (K >> 1);
  float ss = 0.f;
  for (int c = 0; c < (K >> 4); ++c) {
    float v[8];
    unpack8(*(const uint4*)(p + c * 8), v);
#pragma unroll
    for (int j = 0; j < 8; ++j) ss += v[j] * v[j];
  }
  ss += __shfl_xor(ss, 1);
  if (half == 0) rs[row] = rsqrtf(ss / (float)K + 1e-6f);
  __syncthreads();
}

DI void qproj_tile(const Params& P, const Grp& G, int it, char* ldsraw) {
  u16* lds = (u16*)ldsraw;
  float* rs = (float*)(ldsraw + LDS_MAIN);
  int mtile = it / 6, ntile = it % 6;
  int m0 = mtile * 128, n0 = ntile * 128;
  const u16* A = pU(P) + (size_t)m0 * UC + C_CQ;
  rowstat(A, UC, 384, rs);
  f32x16 acc[2][2];
  acc[0][0] = zero16(); acc[0][1] = zero16(); acc[1][0] = zero16(); acc[1][1] = zero16();
  gemm_mainloop(A, UC, pWUQ(P) + (size_t)n0 * 384, 384, 384, lds, acc);
  gemm_epilogue(acc, (float*)ldsraw, [&](int row, int col, float* v) {
    int n = n0 + col, lt = m0 + row;
    float s = rs[row];
#pragma unroll
    for (int j = 0; j < 8; ++j) v[j] *= s;
    int d = n % 96;
    if (G.latent && d >= 64) rope8(v, (d - 64) >> 1, lt & 2047);
    *(uint4*)&pQ(P)[(size_t)lt * 768 + n] = pack8(v);
  });
}

DI void kvexp_tile(const Params& P, const Grp& G, int l, int it, char* ldsraw) {
  u16* lds = (u16*)ldsraw;
  float* rs = (float*)(ldsraw + LDS_MAIN);
  int mtile = it >> 3, ntile = it & 7;
  int n0 = ntile * 128;
  const bool cache = mtile >= 64;
  int m0 = (cache ? (mtile - 64) : mtile) * 128;
  const u16* A;
  int lda;
  const u16* W;
  if (!cache) {
    A = pU(P) + (size_t)m0 * UC + C_CKV; lda = UC; W = pWUKVF(P);
    rowstat(A, UC, 256, rs);
  } else {
    A = pCKVC(P) + (size_t)m0 * 256; lda = 256; W = pWUKV(P);
    if (otid() < 128) rs[otid()] = 1.f;
    __syncthreads();
  }
  f32x16 acc[2][2];
  acc[0][0] = zero16(); acc[0][1] = zero16(); acc[1][0] = zero16(); acc[1][1] = zero16();
  gemm_mainloop(A, lda, W + (size_t)n0 * 256, 256, 256, lds, acc);
  gemm_epilogue(acc, (float*)ldsraw, [&](int row, int col, float* v) {
    int n = n0 + col, lr = m0 + row;
    float s = rs[row];
#pragma unroll
    for (int j = 0; j < 8; ++j) v[j] *= s;
    size_t kvrow;
    if (!G.latent) kvrow = lr;
    else if (!cache) kvrow = (size_t)(lr >> 11) * 2304 + 256 + (lr & 2047);
    else kvrow = (size_t)(lr >> 8) * 2304 + (lr & 255);
    *(uint4*)&pKV(P)[kvrow * 1024 + n] = pack8(v);
  });
  if (!G.latent && ntile == 0) {
    const float* kg = P.kv_norm_g + l * 256;
    for (int c = otid(); c < 128 * 32; c += 256) {
      int row = c >> 5, c8 = (c & 31) * 8;
      int lt = m0 + row;
      float v[8];
      unpack8(*(const uint4*)&pU(P)[(size_t)lt * UC + C_CKV + c8], v);
      float s = rs[row];
      float* dst = P.out + OUT_CKV + (((size_t)(lt >> 8) * 2 + l) * 256 + (lt & 255)) * 256 + c8;
      *(float4*)dst = make_float4(v[0] * s * kg[c8], v[1] * s * kg[c8 + 1], v[2] * s * kg[c8 + 2], v[3] * s * kg[c8 + 3]);
      *(float4*)(dst + 4) = make_float4(v[4] * s * kg[c8 + 4], v[5] * s * kg[c8 + 5], v[6] * s * kg[c8 + 6], v[7] * s * kg[c8 + 7]);
    }
    __syncthreads();
  }
}

DI f32x16 mm64_tile(const u16* A, const u16* Bt, int tm, int tn, int r, int h) {
  f32x16 acc = zero16();
  const u16* pa = A + (32 * tm + r) * 72 + 8 * h;
  const u16* pb = Bt + (32 * tn + r) * 72 + 8 * h;
#pragma unroll
  for (int s = 0; s < 4; ++s) acc = MFMA32(*(const bf16x8*)(pa + 16 * s), *(const bf16x8*)(pb + 16 * s), acc);
  return acc;
}

DI void gdn_prep_item(const Params& P, const Grp& G, int l, int it, char* ldsraw) {
  const int tid0 = otid();
  int t2 = it;
  const int N = G.nchunk;
  const int ctok = t2 % N; t2 /= N;
  const int head = t2 & 7, sl = t2 >> 3;
  u16* lds = (u16*)ldsraw;
  u16* Kn = lds;
  u16* Qn = lds + 4608;
  u16* VTb = lds + 9216;
  u16* KTb = lds + 13824;
  u16* KdT = lds + 18432;
  u16* AT = lds + 23040;
  float* Lf = (float*)(lds + 27648);
  float* sm = (float*)(ldsraw + LDS_MAIN);
  float* s_gc = sm; float* s_beta = sm + 64; float* s_eg = sm + 128; float* s_ekd = sm + 192;

  unsigned yp[3][8];
  {
    const int i = tid0 >> 2, part = tid0 & 3;
    const int tpos = ctok * 64 + i;
    const size_t lt = (size_t)sl * G.seqlen + tpos;
#pragma unroll
    for (int m = 0; m < 3; ++m) {
      const int cb = C_Q + m * 512 + head * 64 + part * 16;
      const float* cw = P.conv_qkv_w + (size_t)l * 3 * 1536 + m * 512 + head * 64 + part * 16;
      float y[16];
#pragma unroll
      for (int hf = 0; hf < 2; ++hf) {
        float xc[8], xm[8], xp[8];
        unpack8(*(const uint4*)&pU(P)[lt * UC + cb + hf * 8], xc);
        if (tpos > 0) unpack8(*(const uint4*)&pU(P)[(lt - 1) * UC + cb + hf * 8], xm);
        else { for (int j = 0; j < 8; ++j) xm[j] = 0.f; }
        if (tpos < G.seqlen - 1) unpack8(*(const uint4*)&pU(P)[(lt + 1) * UC + cb + hf * 8], xp);
        else { for (int j = 0; j < 8; ++j) xp[j] = 0.f; }
        float w0[8], w1[8], w2[8];
        *(float4*)&w0[0] = *(const float4*)(cw + hf * 8); *(float4*)&w0[4] = *(const float4*)(cw + hf * 8 + 4);
        *(float4*)&w1[0] = *(const float4*)(cw + 1536 + hf * 8); *(float4*)&w1[4] = *(const float4*)(cw + 1536 + hf * 8 + 4);
        *(float4*)&w2[0] = *(const float4*)(cw + 3072 + hf * 8); *(float4*)&w2[4] = *(const float4*)(cw + 3072 + hf * 8 + 4);
#pragma unroll
        for (int j = 0; j < 8; ++j) y[hf * 8 + j] = silu_f(xm[j] * w0[j] + xc[j] * w1[j] + xp[j] * w2[j]);
      }
      if (m < 2) {
        float sq = 0.f;
#pragma unroll
        for (int j = 0; j < 16; ++j) sq += y[j] * y[j];
        sq += __shfl_xor(sq, 1); sq += __shfl_xor(sq, 2);
        float iq = rsqrtf(sq + 1e-6f) * ((m == 0) ? 0.125f : 1.f);
#pragma unroll
        for (int j = 0; j < 16; ++j) y[j] *= iq;
      }
#pragma unroll
      for (int j = 0; j < 8; ++j) yp[m][j] = pk2(y[2 * j], y[2 * j + 1]);
    }
  }
  int ndir = 2;
  asm volatile("" : "+s"(ndir));
  for (int dir = 0; dir < ndir; ++dir) {
  const int tid = otid(), lane = tid & 63, w = tid >> 6, r = lane & 31, h = lane >> 5;
  const int i = tid >> 2, part = tid & 3;
  if (tid < 64) {
    const int ti = tid;
    const int tp = dir ? (ctok * 64 + 63 - ti) : (ctok * 64 + ti);
    const size_t ltg = (size_t)sl * G.seqlen + tp;
    float a = pGAB(P)[ltg * 32 + dir * 8 + head];
    float b = pGAB(P)[ltg * 32 + 16 + dir * 8 + head];
    float xs = a + P.dt_bias[l * 16 + dir * 8 + head];
    float sp = (xs > 20.f) ? xs : log1pf(__expf(xs));
    float g = -__expf(P.a_log[l * 16 + dir * 8 + head]) * sp;
#pragma unroll
    for (int off = 1; off < 64; off <<= 1) {
      float t = __shfl_up(g, off);
      if (ti >= off) g += t;
    }
    float gl = __shfl(g, 63);
    s_gc[ti] = g; s_beta[ti] = sigmoid_f(b); s_eg[ti] = __expf(g); s_ekd[ti] = __expf(gl - g);
  }
  __syncthreads();
  {
    const int ri = dir ? (63 - i) : i;
    const float be = s_beta[ri], eg = s_eg[ri], ekd = s_ekd[ri];
    *(uint4*)&Qn[ri * 72 + part * 16] = make_uint4(yp[0][0], yp[0][1], yp[0][2], yp[0][3]);
    *(uint4*)&Qn[ri * 72 + part * 16 + 8] = make_uint4(yp[0][4], yp[0][5], yp[0][6], yp[0][7]);
    *(uint4*)&Kn[ri * 72 + part * 16] = make_uint4(yp[1][0], yp[1][1], yp[1][2], yp[1][3]);
    *(uint4*)&Kn[ri * 72 + part * 16 + 8] = make_uint4(yp[1][4], yp[1][5], yp[1][6], yp[1][7]);
#pragma unroll
    for (int j = 0; j < 8; ++j) {
      const int cc = part * 16 + 2 * j;
      const float k0 = bflo(yp[1][j]), k1 = bfhi(yp[1][j]), v0 = bflo(yp[2][j]), v1 = bfhi(yp[2][j]);
      KTb[cc * 72 + ri] = f2bf(k0 * be * eg);  KTb[(cc + 1) * 72 + ri] = f2bf(k1 * be * eg);
      KdT[cc * 72 + ri] = f2bf(k0 * ekd);      KdT[(cc + 1) * 72 + ri] = f2bf(k1 * ekd);
      VTb[cc * 72 + ri] = f2bf(v0 * be);       VTb[(cc + 1) * 72 + ri] = f2bf(v1 * be);
    }
  }
  __syncthreads();
  const int tm = w >> 1, tn = w & 1;
  {
    f32x16 aK = mm64_tile(Kn, Kn, tm, tn, r, h);
    f32x16 aQ = mm64_tile(Qn, Kn, tm, tn, r, h);
    const int jj = 32 * tn + r;
    const float gcj = s_gc[jj];
#pragma unroll
    for (int ii = 0; ii < 16; ++ii) {
      const int ri = 32 * tm + crow(ii, h);
      float dec = (ri >= jj) ? __expf(s_gc[ri] - gcj) : 0.f;
      Lf[ri * 72 + jj] = (ri > jj) ? s_beta[ri] * aK[ii] * dec : 0.f;
      AT[ri * 72 + jj] = f2bf(aQ[ii] * dec);
    }
  }
  __syncthreads();
  float* Pf = (float*)Kn;
  if (w == 0) {
    const int b = lane >> 4, c = lane & 15;
    float t[16];
#pragma unroll
    for (int a = 0; a < 16; ++a) {
      float s = (a == c) ? 1.f : 0.f;
#pragma unroll
      for (int j = 0; j < a; ++j) s -= Lf[(16 * b + a) * 72 + 16 * b + j] * t[j];
      t[a] = s;
    }
#pragma unroll
    for (int a = 0; a < 16; ++a) Lf[(16 * b + a) * 72 + 16 * b + c] = t[a];
  }
  __syncthreads();
  for (int idx = tid; idx < 512; idx += 256) {
    const int p = idx >> 8, a = (idx >> 4) & 15, j = idx & 15;
    float s = 0.f;
#pragma unroll
    for (int k = 0; k < 16; ++k) s += Lf[(32 * p + 16 + a) * 72 + 32 * p + k] * Lf[(32 * p + k) * 72 + 32 * p + j];
    Pf[p * 256 + a * 16 + j] = s;
  }
  __syncthreads();
  for (int idx = tid; idx < 512; idx += 256) {
    const int p = idx >> 8, a = (idx >> 4) & 15, j = idx & 15;
    float s = 0.f;
#pragma unroll
    for (int k = 0; k < 16; ++k) s += Lf[(32 * p + 16 + a) * 72 + 32 * p + 16 + k] * Pf[p * 256 + k * 16 + j];
    Lf[(32 * p + 16 + a) * 72 + 32 * p + j] = -s;
  }
  __syncthreads();
  if (w == 0) {
    f32x16 acc = zero16();
#pragma unroll
    for (int s2 = 0; s2 < 16; ++s2)
      acc = __builtin_amdgcn_mfma_f32_32x32x2f32(Lf[(32 + r) * 72 + 2 * s2 + h], Lf[(2 * s2 + h) * 72 + r], acc, 0, 0, 0);
#pragma unroll
    for (int ii = 0; ii < 16; ++ii) Pf[crow(ii, h) * 32 + r] = acc[ii];
  }
  __syncthreads();
  if (w == 0) {
    f32x16 acc = zero16();
#pragma unroll
    for (int s2 = 0; s2 < 16; ++s2)
      acc = __builtin_amdgcn_mfma_f32_32x32x2f32(Lf[(32 + r) * 72 + 32 + 2 * s2 + h], Pf[(2 * s2 + h) * 32 + r], acc, 0, 0, 0);
#pragma unroll
    for (int ii = 0; ii < 16; ++ii) Lf[(32 + crow(ii, h)) * 72 + r] = -acc[ii];
  }
  __syncthreads();
  u16* Tb = Kn;
  for (int idx = tid; idx < 4096; idx += 256) {
    const int a = idx >> 6, j = idx & 63;
    Tb[a * 72 + j] = f2bf(Lf[a * 72 + j]);
  }
  __syncthreads();
  u16* UT = (u16*)Lf;
  u16* WT = UT + 4608;
  {
    f32x16 aU = mm64_tile(Tb, VTb, tm, tn, r, h);
    f32x16 aW = mm64_tile(Tb, KTb, tm, tn, r, h);
    __syncthreads();
#pragma unroll
    for (int g4 = 0; g4 < 4; ++g4) {
      const int ci = 32 * tm + 8 * g4 + 4 * h;
      *(uint2*)&UT[(32 * tn + r) * 72 + ci] = make_uint2(pk2(aU[4 * g4], aU[4 * g4 + 1]), pk2(aU[4 * g4 + 2], aU[4 * g4 + 3]));
      *(uint2*)&WT[(32 * tn + r) * 72 + ci] = make_uint2(pk2(aW[4 * g4], aW[4 * g4 + 1]), pk2(aW[4 * g4 + 2], aW[4 * g4 + 3]));
    }
  }
  __syncthreads();
  {
    const int cdir = dir ? (N - 1 - ctok) : ctok;
    u16* gd = pGD(P) + ((((size_t)dir * G.nseq + sl) * 8 + head) * N + cdir) * 16384;
    f32x16 a1 = mm64_tile(AT, WT, tm, tn, r, h);
    f32x16 a3 = mm64_tile(KdT, WT, tm, tn, r, h);
    const int cc = 32 * tn + r;
    const int pc = swap23(cc);
    const float egl = s_eg[63];
#pragma unroll
    for (int ii = 0; ii < 16; ++ii) {
      const int ri = 32 * tm + crow(ii, h);
      float qe = bf2f(Qn[ri * 72 + cc]) * s_eg[ri] - a1[ii];
      float mc = ((ri == cc) ? egl : 0.f) - a3[ii];
      gd[ri * 64 + pc] = f2bf(qe);
      gd[4096 + ri * 64 + pc] = f2bf(mc);
    }
    f32x16 a2 = mm64_tile(AT, UT, tm, tn, r, h);
    f32x16 a4 = mm64_tile(KdT, UT, tm, tn, r, h);
    u16* o3 = gd + 3 * 4096 + ((tm * 2 + tn) * 64 + lane) * 16;
    u16* o2 = gd + 2 * 4096 + ((tm * 2 + tn) * 64 + lane) * 16;
    *(uint4*)o3 = make_uint4(pk2(a2[0], a2[1]), pk2(a2[2], a2[3]), pk2(a2[4], a2[5]), pk2(a2[6], a2[7]));
    *(uint4*)(o3 + 8) = make_uint4(pk2(a2[8], a2[9]), pk2(a2[10], a2[11]), pk2(a2[12], a2[13]), pk2(a2[14], a2[15]));
    *(uint4*)o2 = make_uint4(pk2(a4[0], a4[1]), pk2(a4[2], a4[3]), pk2(a4[4], a4[5]), pk2(a4[6], a4[7]));
    *(uint4*)(o2 + 8) = make_uint4(pk2(a4[8], a4[9]), pk2(a4[10], a4[11]), pk2(a4[12], a4[13]), pk2(a4[14], a4[15]));
  }
  __syncthreads();
  }
}

DI f32x16 unpack16(const u16* p) {
  uint4 a = *(const uint4*)p, b = *(const uint4*)(p + 8);
  f32x16 v;
  v[0] = bflo(a.x); v[1] = bfhi(a.x); v[2] = bflo(a.y); v[3] = bfhi(a.y); v[4] = bflo(a.z); v[5] = bfhi(a.z); v[6] = bflo(a.w); v[7] = bfhi(a.w);
  v[8] = bflo(b.x); v[9] = bfhi(b.x); v[10] = bflo(b.y); v[11] = bfhi(b.y); v[12] = bflo(b.z); v[13] = bfhi(b.z); v[14] = bflo(b.w); v[15] = bfhi(b.w);
  return v;
}

struct ScanOps { bf16x8 qa[2][4], ma[2][4]; u32x4 bc[2][2], ou[2][2]; };
DI void scan_load(ScanOps& o, const u16* mb, int r, int h, int nt, int lane) {
#pragma unroll
  for (int mt = 0; mt < 2; ++mt) {
#pragma unroll
    for (int ks = 0; ks < 4; ++ks) {
      o.qa[mt][ks] = *(const bf16x8*)(mb + (32 * mt + r) * 64 + 16 * ks + 8 * h);
      o.ma[mt][ks] = *(const bf16x8*)(mb + 4096 + (32 * mt + r) * 64 + 16 * ks + 8 * h);
    }
    const u16* pb = mb + 2 * 4096 + ((mt * 2 + nt) * 64 + lane) * 16;
    const u16* po = mb + 3 * 4096 + ((mt * 2 + nt) * 64 + lane) * 16;
    o.bc[mt][0] = *(const u32x4*)pb; o.bc[mt][1] = *(const u32x4*)(pb + 8);
    o.ou[mt][0] = *(const u32x4*)po; o.ou[mt][1] = *(const u32x4*)(po + 8);
  }
}
DI f32x16 unpack16v(u32x4 a, u32x4 b) {
  f32x16 v;
  v[0] = bflo(a[0]); v[1] = bfhi(a[0]); v[2] = bflo(a[1]); v[3] = bfhi(a[1]); v[4] = bflo(a[2]); v[5] = bfhi(a[2]); v[6] = bflo(a[3]); v[7] = bfhi(a[3]);
  v[8] = bflo(b[0]); v[9] = bfhi(b[0]); v[10] = bflo(b[1]); v[11] = bfhi(b[1]); v[12] = bflo(b[2]); v[13] = bfhi(b[2]); v[14] = bflo(b[3]); v[15] = bfhi(b[3]);
  return v;
}
DI void scan_step(const ScanOps& o, f32x16 (&S)[2], u16* obuf, size_t rowbase, int ctok, int dir, int colbase, int h) {
  f32x16 ov[2], Sn[2];
#pragma unroll
  for (int mt = 0; mt < 2; ++mt) {
    Sn[mt] = unpack16v(o.bc[mt][0], o.bc[mt][1]);
    ov[mt] = unpack16v(o.ou[mt][0], o.ou[mt][1]);
  }
  bf16x8 Sb[4];
  Sb[0] = pack_frag(S[0], 0); Sb[1] = pack_frag(S[0], 1); Sb[2] = pack_frag(S[1], 0); Sb[3] = pack_frag(S[1], 1);
#pragma unroll
  for (int mt = 0; mt < 2; ++mt)
#pragma unroll
    for (int ks = 0; ks < 4; ++ks) {
      ov[mt] = MFMA32(o.qa[mt][ks], Sb[ks], ov[mt]);
      Sn[mt] = MFMA32(o.ma[mt][ks], Sb[ks], Sn[mt]);
    }
#pragma unroll
  for (int mt = 0; mt < 2; ++mt)
#pragma unroll
    for (int ii = 0; ii < 16; ++ii) {
      int ri = 32 * mt + crow(ii, h);
      int tpos = dir ? (ctok * 64 + 63 - ri) : (ctok * 64 + ri);
      obuf[(rowbase + tpos) * 512 + colbase] = f2bf(ov[mt][ii]);
    }
  S[0] = Sn[0]; S[1] = Sn[1];
}

DI void gdn_scan_item(const Params& P, const Grp& G, int l, int it) {
  const int tid = otid(), lane = tid & 63, w = tid >> 6, r = lane & 31, h = lane >> 5;
  const int head = it & 7, sl = it >> 3;
  const int dir = w >> 1, nt = w & 1;
  const int N = G.nchunk;
  f32x16 S[2];
  if (G.latent) {
    const float* st = P.state_gdn + ((((size_t)(G.seq0 + sl) * 2 + l) * 2 + dir) * 8 + head) * 4096;
#pragma unroll
    for (int mt = 0; mt < 2; ++mt)
#pragma unroll
      for (int ii = 0; ii < 16; ++ii) S[mt][ii] = st[(32 * mt + crow(ii, h)) * 64 + 32 * nt + r];
  } else { S[0] = zero16(); S[1] = zero16(); }
  const u16* base = pGD(P) + ((((size_t)dir * G.nseq + sl) * 8 + head) * N) * 16384;
  u16* obuf = dir ? pOR(P) : pOF(P);
  const size_t rowbase = (size_t)sl * G.seqlen;
  const int colbase = head * 64 + 32 * nt + r;
  ScanOps oa;
  for (int c = 0; c < N; ++c) {
    scan_load(oa, base + (size_t)c * 16384, r, h, nt, lane);
    scan_step(oa, S, obuf, rowbase, dir ? (N - 1 - c) : c, dir, colbase, h);
  }
  if (!G.latent) {
    float* st = P.out + OUT_ST + ((((size_t)sl * 2 + l) * 2 + dir) * 8 + head) * 4096;
#pragma unroll
    for (int mt = 0; mt < 2; ++mt)
#pragma unroll
      for (int ii = 0; ii < 16; ++ii) st[(32 * mt + crow(ii, h)) * 64 + 32 * nt + r] = S[mt][ii];
  }
  asm volatile("s_waitcnt vmcnt(0)" ::: "memory");
  __syncthreads();
  const float* gn = P.gdn_norm_g + l * 64;
#pragma unroll 4
  for (int idx = tid; idx < G.seqlen * 8; idx += 256) {
    int tpos = idx >> 3, part = idx & 7;
    size_t lt = (size_t)sl * G.seqlen + tpos;
    float a[8], b[8], z[8];
    unpack8(*(const uint4*)&pOF(P)[lt * 512 + head * 64 + part * 8], a);
    unpack8(*(const uint4*)&pOR(P)[lt * 512 + head * 64 + part * 8], b);
    u16* zp = &pU(P)[lt * UC + C_Z + head * 64 + part * 8];
    unpack8(*(const uint4*)zp, z);
    float ss = 0.f;
#pragma unroll
    for (int j = 0; j < 8; ++j) { a[j] += b[j]; ss += a[j] * a[j]; }
    ss += __shfl_xor(ss, 1); ss += __shfl_xor(ss, 2); ss += __shfl_xor(ss, 4);
    float rstd = rsqrtf(ss * (1.f / 64.f) + 1e-6f);
#pragma unroll
    for (int j = 0; j < 8; ++j) a[j] = a[j] * rstd * gn[part * 8 + j] * silu_f(z[j]);
    *(uint4*)zp = pack8(a);
  }
  __syncthreads();
}

struct KvRegs { u32x4 k[2], kr, v[2]; };
DI void attn_gload(KvRegs& g, const u16* kvp, const u16* krp, size_t row0, int tid, int head) {
#pragma unroll
  for (int i2 = 0; i2 < 2; ++i2) {
    int c = tid + 256 * i2;
    int key = c >> 3, d8 = (c & 7) * 8;
    const u16* src = &kvp[(row0 + key) * 1024 + head * 128 + d8];
    g.k[i2] = *(const u32x4*)src;
    g.v[i2] = *(const u32x4*)(src + 64);
  }
  g.kr = *(const u32x4*)&krp[(row0 + (tid >> 2)) * 32 + (tid & 3) * 8];
}
DI void attn_lstore(const KvRegs& g, u16* Kl, u16* Vt, int tid) {
#pragma unroll
  for (int i2 = 0; i2 < 2; ++i2) {
    int c = tid + 256 * i2;
    int key = c >> 3, d8 = (c & 7) * 8;
    *(u32x4*)&Kl[key * 104 + d8] = g.k[i2];
    u32x4 vv = g.v[i2];
    u16* vd = &Vt[d8 * 72 + key];
    vd[0] = (u16)(vv[0] & 0xffff); vd[72] = (u16)(vv[0] >> 16); vd[144] = (u16)(vv[1] & 0xffff); vd[216] = (u16)(vv[1] >> 16);
    vd[288] = (u16)(vv[2] & 0xffff); vd[360] = (u16)(vv[2] >> 16); vd[432] = (u16)(vv[3] & 0xffff); vd[504] = (u16)(vv[3] >> 16);
  }
  *(u32x4*)&Kl[(tid >> 2) * 104 + 64 + (tid & 3) * 8] = g.kr;
}
DI void attn_tile(const u16* Kl, const u16* Vt, const bf16x8 (&qf)[6], f32x16 (&O)[2], float& mrun, float& lrun, int r, int h) {
  const float sc = 0.14724455f;
  f32x16 st[2];
#pragma unroll
  for (int mt = 0; mt < 2; ++mt) {
    st[mt] = zero16();
#pragma unroll
    for (int s = 0; s < 6; ++s) st[mt] = MFMA32(*(const bf16x8*)&Kl[(32 * mt + r) * 104 + 16 * s + 8 * h], qf[s], st[mt]);
  }
  float mloc = -1e30f;
#pragma unroll
  for (int mt = 0; mt < 2; ++mt)
#pragma unroll
    for (int ii = 0; ii < 16; ++ii) { st[mt][ii] *= sc; mloc = fmaxf(mloc, st[mt][ii]); }
  mloc = fmaxf(mloc, __shfl_xor(mloc, 32));
  const float mnew = fmaxf(mrun, mloc);
  const float alpha = __builtin_amdgcn_exp2f(mrun - mnew);
  mrun = mnew;
  float ps = 0.f;
#pragma unroll
  for (int mt = 0; mt < 2; ++mt)
#pragma unroll
    for (int ii = 0; ii < 16; ++ii) { float p = __builtin_amdgcn_exp2f(st[mt][ii] - mnew); st[mt][ii] = p; ps += p; }
  lrun = lrun * alpha + ps;
#pragma unroll
  for (int ii = 0; ii < 16; ++ii) { O[0][ii] *= alpha; O[1][ii] *= alpha; }
#pragma unroll
  for (int mt = 0; mt < 2; ++mt)
#pragma unroll
    for (int s2 = 0; s2 < 2; ++s2) {
      bf16x8 pb = pack_frag(st[mt], s2);
#pragma unroll
      for (int dvt = 0; dvt < 2; ++dvt) {
        const u16* vp = &Vt[(32 * dvt + r) * 72 + 32 * mt + 16 * s2 + 4 * h];
        s16x4 lo = *(const s16x4*)vp;
        s16x4 hi = *(const s16x4*)(vp + 8);
        bf16x8 va = __builtin_shufflevector(lo, hi, 0, 1, 2, 3, 4, 5, 6, 7);
        O[dvt] = MFMA32(va, pb, O[dvt]);
      }
    }
}

DI void attn_item(const Params& P, const Grp& G, int it, char* ldsraw) {
  const int tid = otid(), lane = tid & 63, w = tid >> 6, r = lane & 31, h = lane >> 5;
  const int nqb = G.seqlen >> 7;
  const int qb = it % nqb, head = (it / nqb) & 7, sl = it / (nqb * 8);
  u16* Kl0 = (u16*)ldsraw;
  u16* Vt0 = Kl0 + 64 * 104;
  u16* Kl1 = Vt0 + 64 * 72;
  u16* Vt1 = Kl1 + 64 * 104;
  const size_t ltq = (size_t)sl * G.seqlen + qb * 128 + w * 32 + r;
  bf16x8 qf[6];
#pragma unroll
  for (int s = 0; s < 6; ++s) qf[s] = *(const bf16x8*)&pQ(P)[ltq * 768 + head * 96 + s * 16 + h * 8];
  const int nkt = G.kvlen >> 6;
  const size_t kvbase = (size_t)sl * G.kvlen;
  const u16* kvp = pKV(P);
  const u16* krp = pKR(P);
  float mrun = -1e30f, lrun = 0.f;
  f32x16 O[2];
  O[0] = zero16(); O[1] = zero16();
  KvRegs g0, g1;
  attn_gload(g0, kvp, krp, kvbase, tid, head);
  attn_gload(g1, kvp, krp, kvbase + 64, tid, head);
  __syncthreads();
  attn_lstore(g0, Kl0, Vt0, tid);
  __syncthreads();
  for (int kt = 0; kt < nkt; kt += 2) {
    if (kt + 2 < nkt) attn_gload(g0, kvp, krp, kvbase + (size_t)(kt + 2) * 64, tid, head);
    attn_tile(Kl0, Vt0, qf, O, mrun, lrun, r, h);
    attn_lstore(g1, Kl1, Vt1, tid);
    __syncthreads();
    if (kt + 3 < nkt) attn_gload(g1, kvp, krp, kvbase + (size_t)(kt + 3) * 64, tid, head);
    attn_tile(Kl1, Vt1, qf, O, mrun, lrun, r, h);
    if (kt + 2 < nkt) attn_lstore(g0, Kl0, Vt0, tid);
    __syncthreads();
  }
  const float ltot = lrun + __shfl_xor(lrun, 32);
  const float inv = 1.f / ltot;
#pragma unroll
  for (int dvt = 0; dvt < 2; ++dvt)
#pragma unroll
    for (int g4 = 0; g4 < 4; ++g4) {
      u16* gp = &pU(P)[ltq * UC + C_GA + head * 64 + 32 * dvt + 8 * g4 + 4 * h];
      uint2 gw = *(const uint2*)gp;
      float o0 = O[dvt][4 * g4] * inv * silu_f(bflo(gw.x));
      float o1 = O[dvt][4 * g4 + 1] * inv * silu_f(bfhi(gw.x));
      float o2 = O[dvt][4 * g4 + 2] * inv * silu_f(bflo(gw.y));
      float o3 = O[dvt][4 * g4 + 3] * inv * silu_f(bfhi(gw.y));
      *(uint2*)gp = make_uint2(pk2(o0, o1), pk2(o2, o3));
    }
}

DI void convb_item(const Params& P, const Grp& G, int l, int it) {
  const int tid = otid();
  const float* cw = P.conv_b_w + (size_t)l * 3 * 512;
  for (int rep = 0; rep < 16; ++rep) {
    int c = tid + 256 * rep;
    int row = c >> 6, c8 = (c & 63) * 8;
    size_t lt = (size_t)it * 64 + row;
    int tpos = (int)(lt % G.seqlen);
    float cc[8], xx[8], pm[8], p0[8], pp[8], bb[8], gg[8];
    unpack8(*(const uint4*)&pU(P)[lt * UC + C_C + c8], cc);
    unpack8(*(const uint4*)&pU(P)[lt * UC + C_X + c8], xx);
#pragma unroll
    for (int j = 0; j < 8; ++j) p0[j] = cc[j] * xx[j];
    if (tpos > 0) {
      unpack8(*(const uint4*)&pU(P)[(lt - 1) * UC + C_C + c8], cc);
      unpack8(*(const uint4*)&pU(P)[(lt - 1) * UC + C_X + c8], xx);
#pragma unroll
      for (int j = 0; j < 8; ++j) pm[j] = cc[j] * xx[j];
    } else { for (int j = 0; j < 8; ++j) pm[j] = 0.f; }
    if (tpos < G.seqlen - 1) {
      unpack8(*(const uint4*)&pU(P)[(lt + 1) * UC + C_C + c8], cc);
      unpack8(*(const uint4*)&pU(P)[(lt + 1) * UC + C_X + c8], xx);
#pragma unroll
      for (int j = 0; j < 8; ++j) pp[j] = cc[j] * xx[j];
    } else { for (int j = 0; j < 8; ++j) pp[j] = 0.f; }
    unpack8(*(const uint4*)&pU(P)[lt * UC + C_B + c8], bb);
    u16* gp = &pU(P)[lt * UC + C_GB + c8];
    unpack8(*(const uint4*)gp, gg);
    float o[8];
#pragma unroll
    for (int j = 0; j < 8; ++j)
      o[j] = bb[j] * (pm[j] * cw[c8 + j] + p0[j] * cw[512 + c8 + j] + pp[j] * cw[1024 + c8 + j]) * silu_f(gg[j]);
    *(uint4*)gp = pack8(o);
  }
}

DI void merge_tile(const Params& P, int it, char* ldsraw) {
  u16* lds = (u16*)ldsraw;
  const int mtile = (it & 7) * 8 + ((it >> 3) & 7), ntile = it >> 6;
  const int m0 = mtile * 128, n0 = ntile * 128;
  u16* Mb = pKV(P);
  unsigned mp[2][2][8];
#pragma unroll 1
  for (int br = 0; br < 3; ++br) {
    f32x16 acc[2][2];
    acc[0][0] = zero16(); acc[0][1] = zero16(); acc[1][0] = zero16(); acc[1][1] = zero16();
    gemm_mainloop(pH(P) + (size_t)m0 * 1024, 1024, pWT1(P) + (size_t)(C_MG + br * 1024 + n0) * 1024, 1024, 1024, lds, acc);
    unsigned sg[2][2][4];
#pragma unroll
    for (int a2 = 0; a2 < 2; ++a2)
#pragma unroll
      for (int b2 = 0; b2 < 2; ++b2)
#pragma unroll
        for (int i = 0; i < 4; ++i) {
          unsigned q0 = (unsigned)(sigmoid_f(acc[a2][b2][4 * i]) * 255.f + 0.5f), q1 = (unsigned)(sigmoid_f(acc[a2][b2][4 * i + 1]) * 255.f + 0.5f);
          unsigned q2 = (unsigned)(sigmoid_f(acc[a2][b2][4 * i + 2]) * 255.f + 0.5f), q3 = (unsigned)(sigmoid_f(acc[a2][b2][4 * i + 3]) * 255.f + 0.5f);
          sg[a2][b2][i] = q0 | (q1 << 8) | (q2 << 16) | (q3 << 24);
        }
    acc[0][0] = zero16(); acc[0][1] = zero16(); acc[1][0] = zero16(); acc[1][1] = zero16();
    const int ocol = (br == 0) ? C_GA : (br == 1 ? C_GB : C_Z);
    const u16* Wp = (br == 0) ? pWPA(P) : (br == 1 ? pWPB(P) : pWPC(P));
    gemm_mainloop1(pU(P) + (size_t)m0 * UC + ocol, UC, Wp + (size_t)n0 * 512, 512, 512, lds, acc);
#pragma unroll
    for (int a2 = 0; a2 < 2; ++a2)
#pragma unroll
      for (int b2 = 0; b2 < 2; ++b2)
#pragma unroll
        for (int i = 0; i < 4; ++i) {
          const unsigned wq = sg[a2][b2][i];
          acc[a2][b2][4 * i] *= (float)(wq & 255u) * (1.f / 255.f);
          acc[a2][b2][4 * i + 1] *= (float)((wq >> 8) & 255u) * (1.f / 255.f);
          acc[a2][b2][4 * i + 2] *= (float)((wq >> 16) & 255u) * (1.f / 255.f);
          acc[a2][b2][4 * i + 3] *= (float)(wq >> 24) * (1.f / 255.f);
        }
    if (br < 2) {
#pragma unroll
      for (int a2 = 0; a2 < 2; ++a2)
#pragma unroll
        for (int b2 = 0; b2 < 2; ++b2)
#pragma unroll
          for (int i = 0; i < 8; ++i) {
            float lo = acc[a2][b2][2 * i], hi = acc[a2][b2][2 * i + 1];
            if (br > 0) { lo += bflo(mp[a2][b2][i]); hi += bfhi(mp[a2][b2][i]); }
            mp[a2][b2][i] = pk2(lo, hi);
          }
    } else {
#pragma unroll
      for (int a2 = 0; a2 < 2; ++a2)
#pragma unroll
        for (int b2 = 0; b2 < 2; ++b2)
#pragma unroll
          for (int i = 0; i < 8; ++i) { acc[a2][b2][2 * i] += bflo(mp[a2][b2][i]); acc[a2][b2][2 * i + 1] += bfhi(mp[a2][b2][i]); }
      gemm_epilogue(acc, (float*)ldsraw, [&](int row, int col, float* v) {
        *(uint4*)&Mb[(size_t)(m0 + row) * 1024 + n0 + col] = pack8(v);
      });
    }
  }
}

DI void out_tile(const Params& P, const Grp& G, int l, int it, char* ldsraw) {
  u16* lds = (u16*)ldsraw;
  const int mtile = (it & 7) * 8 + ((it >> 3) & 7), ntile = it >> 6;
  const int m0 = mtile * 128, n0 = ntile * 128;
  f32x16 acc[2][2];
  acc[0][0] = zero16(); acc[0][1] = zero16(); acc[1][0] = zero16(); acc[1][1] = zero16();
  gemm_mainloop(pKV(P) + (size_t)m0 * 1024, 1024, pWO(P) + (size_t)n0 * 1024, 1024, 1024, lds, acc);
  gemm_epilogue<4>(acc, (float*)ldsraw, [&](int row, int col, float* v) {
    int lt = m0 + row, n = n0 + col;
    int tok = G.tok0 + lt;
    int cond = G.latent ? 1 + G.seq0 + (lt >> 11) : 0;
    const float* gate = pMOD(P) + (l * 9 + cond) * 3072 + 2048 + n;
    const float* xr = x_row(P, l, tok) + n;
    float4 x0 = *(const float4*)xr, x1 = *(const float4*)(xr + 4);
    float4 g0 = *(const float4*)(gate + 4 * 55296), g1 = *(const float4*)(gate + 4 * 55296 + 4);
    float* dst = P.out + (size_t)tok * 1024 + n;
    *(float4*)dst = make_float4(x0.x + g0.x * v[0], x0.y + g0.y * v[1], x0.z + g0.z * v[2], x0.w + g0.w * v[3]);
    *(float4*)(dst + 4) = make_float4(x1.x + g1.x * v[4], x1.y + g1.y * v[5], x1.z + g1.z * v[6], x1.w + g1.w * v[7]);
  });
}

DI void final_norm_phase(const Params& P) {
  int wave = (blockIdx.x * 256 + otid()) >> 6, lane = otid() & 63, nw = gridDim.x * 4;
  for (int r = wave; r < 24576; r += nw) {
    float* xr = P.out + (size_t)r * 1024;
    float4 v[4];
    float ss = 0.f;
#pragma unroll
    for (int i = 0; i < 4; ++i) {
      v[i] = *(const float4*)(xr + i * 256 + lane * 4);
      ss += v[i].x * v[i].x + v[i].y * v[i].y + v[i].z * v[i].z + v[i].w * v[i].w;
    }
    ss = wave_sum(ss);
    float rstd = rsqrtf(ss * (1.f / 1024.f) + 1e-6f);
#pragma unroll
    for (int i = 0; i < 4; ++i) {
      int col = i * 256 + lane * 4;
      float4 gg = *(const float4*)(P.final_norm_g + col);
      *(float4*)(xr + col) = make_float4(v[i].x * rstd * gg.x, v[i].y * rstd * gg.y, v[i].z * rstd * gg.z, v[i].w * rstd * gg.w);
    }
  }
}

#define XB_TMO      128
#define XB_XCNT(j)  (256  + 64 * (j))
#define XB_XSUB(j)  (1280 + 64 * (j))
#define XB_XGEN(j)  (2304 + 64 * (j))
#define XB_TOP      3328
#define XB_TOPGEN   3392
#define XCD_BAR_WORDS 3456
#define XB_SPIN_CAP (1u << 18)
#define LAS __attribute__((address_space(3)))

__device__ __forceinline__ unsigned xb_ld(unsigned* p)              { return __hip_atomic_load(p, __ATOMIC_RELAXED, __HIP_MEMORY_SCOPE_AGENT); }
__device__ __forceinline__ unsigned xb_add(unsigned* p, unsigned v) { return __hip_atomic_fetch_add(p, v, __ATOMIC_RELAXED, __HIP_MEMORY_SCOPE_AGENT); }
__device__ __forceinline__ unsigned xb_xcc_id() { return (unsigned)__builtin_amdgcn_s_getreg((3 << 11) | 20) & 0xFu; }
#define XB_SPIN(cond, bar) do { unsigned _sp = 0; while (cond) { __builtin_amdgcn_s_sleep(1); \
    if ((++_sp & 255u) == 0u) { if (xb_ld(&(bar)[XB_TMO])) break; if (_sp > XB_SPIN_CAP) { atomicAdd(&(bar)[XB_TMO], 1u); break; } } } } while (0)

struct XcdBarrier {
    unsigned* bar; unsigned x;
    volatile LAS unsigned* st;
};

__device__ __forceinline__ XcdBarrier xcd_barrier_post(unsigned* bar, volatile LAS unsigned* st) {
    XcdBarrier b; b.bar = bar; b.x = xb_xcc_id(); b.st = st;
    if (threadIdx.x == 0) (void)xb_add(&bar[XB_XCNT(b.x)], 1u);
    return b;
}
__device__ __forceinline__ void xcd_barrier_complete(unsigned* bar, unsigned x, unsigned& nloc, unsigned& nx) {
    const unsigned G = gridDim.x * gridDim.y * gridDim.z;
    unsigned sum, cnt, mine, sp = 0u;
    for (;;) {
        sum = 0u; cnt = 0u; mine = 0u;
#pragma unroll
        for (unsigned j = 0; j < 16; ++j) { const unsigned c = xb_ld(&bar[XB_XCNT(j)]); sum += c; cnt += (c > 0u) ? 1u : 0u; mine = (j == x) ? c : mine; }
        if (sum == G) break;
        __builtin_amdgcn_s_sleep(1);
        if ((++sp & 255u) == 0u) { if (xb_ld(&bar[XB_TMO])) break; if (sp > XB_SPIN_CAP) { atomicAdd(&bar[XB_TMO], 1u); break; } }
    }
    nloc = mine > 0u ? mine : 1u; nx = cnt > 0u ? cnt : 1u;
}

__device__ __forceinline__ void xcd_barrier(const XcdBarrier& b) {
    asm volatile("s_waitcnt vmcnt(0)" ::: "memory");
    __syncthreads();
    if (threadIdx.x == 0) {
        unsigned* bar = b.bar;
        __builtin_amdgcn_s_waitcnt(0);
        unsigned nloc = b.st[0], nx = b.st[1];
        if (nloc == 0u) { xcd_barrier_complete(bar, b.x, nloc, nx); b.st[0] = nloc; b.st[1] = nx; }
        const unsigned old = xb_add(&bar[XB_XSUB(b.x)], 1u);
        const unsigned gen = old / nloc;
        if (old + 1u == (gen + 1u) * nloc) {
            __builtin_amdgcn_fence(__ATOMIC_RELEASE, "agent");
            asm volatile("s_waitcnt vmcnt(0)" ::: "memory");
            const unsigned og = xb_add(&bar[XB_TOP], 1u);
            const unsigned tg = og / nx;
            if (og + 1u == (tg + 1u) * nx) xb_add(&bar[XB_TOPGEN], 1u);
            else XB_SPIN(xb_ld(&bar[XB_TOPGEN]) == tg, bar);
            __builtin_amdgcn_fence(__ATOMIC_ACQUIRE, "agent");
            xb_add(&bar[XB_XGEN(b.x)], 1u);
            asm volatile("s_waitcnt vmcnt(0)" ::: "memory");
        } else {
            XB_SPIN(xb_ld(&bar[XB_XGEN(b.x)]) == gen, bar);
            __builtin_amdgcn_fence(__ATOMIC_ACQUIRE, "agent");
            asm volatile("s_waitcnt vmcnt(0)" ::: "memory");
        }
    }
    __syncthreads();
}

#ifndef PROBE
#define PROBE 0
#endif
#define GSYNC() do { xcd_barrier(xb); if (PROBE & 1) xcd_barrier(xb); } while (0)
__global__ void __launch_bounds__(256, 2) mega(Params P) {
  cg::grid_group grid = cg::this_grid();
  __shared__ __attribute__((aligned(16))) char lds[LDS_TOTAL];
  __shared__ __attribute__((aligned(16))) unsigned xb_words[4];
  __shared__ int s_item;
  if (threadIdx.x < 4) xb_words[threadIdx.x] = 0u;
  __syncthreads();
  const XcdBarrier xb = xcd_barrier_post((unsigned*)(P.ws + O_BAR), (volatile LAS unsigned*)xb_words);
  if (P.out == nullptr) grid.sync();
  for (int it = blockIdx.x; it < 384; it += gridDim.x) mod_item(P, it, (float*)lds);
  convert_phase(P, 0, (float*)lds);
  GSYNC();
  norm_phase(P, make_grp(0), 0, true);
  GSYNC();
  for (int l = 0; l < 2; ++l) {
    if (l == 1) { convert_phase(P, 1, (float*)lds); norm_phase(P, make_grp(0), 1); GSYNC(); }
    for (int g = 0; g < 3; ++g) {
      const Grp G = make_grp(g);
      if (l == 0 && g == 0) {
        float* md = pMOD(P);
        for (int i = blockIdx.x * 256 + threadIdx.x; i < 55296; i += gridDim.x * 256)
          md[4 * 55296 + i] = md[i] + md[55296 + i] + md[2 * 55296 + i] + md[3 * 55296 + i];
      }
      for (int rep = 0; rep < ((PROBE & 2) ? 2 : 1); ++rep) gemm1_phase(P, G, l, lds);
      GSYNC();
      for (int rep = 0; rep < ((PROBE & 4) ? 2 : 1); ++rep) {
        const int nq = 64 * 6, nkv = (G.latent ? 72 : 64) * 8, ngd = 128 * 8, nx = 128;
        for (int it = blockIdx.x; it < nq + nkv + ngd + nx; it += gridDim.x) {
          if (it < ngd) gdn_prep_item(P, G, l, it, lds);
          else if (it < ngd + nx) { const int e = it - ngd; gemm1_tile(P, G, l, e >> 1, 6 + (e & 1), lds); }
          else if (it < ngd + nx + nkv) kvexp_tile(P, G, l, it - ngd - nx, lds);
          else qproj_tile(P, G, it - ngd - nx - nkv, lds);
        }
      }
      GSYNC();
      {
        const int nsc = G.nseq * 8, nat = 512, ncv = 128;
        unsigned* ctr = (unsigned*)(P.ws + O_BAR) + (l * 3 + g);
        for (;;) {
          __syncthreads();
          if (threadIdx.x == 0) s_item = (int)atomicAdd(ctr, 1u);
          __syncthreads();
          const int it = s_item;
          if (it >= nsc + nat + ncv) break;
          if (it < nsc) gdn_scan_item(P, G, l, it);
          else if (it < nsc + nat) attn_item(P, G, it - nsc, lds);
          else convb_item(P, G, l, it - nsc - nat);
        }
      }
      GSYNC();
      stagger();
      for (int rep = 0; rep < ((PROBE & 8) ? 2 : 1); ++rep)
        for (int it = blockIdx.x; it < 512; it += gridDim.x) merge_tile(P, it, lds);
      GSYNC();
      for (int it = blockIdx.x; it < 512; it += gridDim.x) out_tile(P, G, l, it, lds);
      if (g < 2) norm_phase(P, make_grp(g + 1), l);
      GSYNC();
    }
  }
  final_norm_phase(P);
}

extern "C" void kernel_launch(void* const* d_in, const int* in_sizes, int n_in, void* d_out, int out_size,
                              void* d_ws, size_t ws_size, hipStream_t stream) {
  static int grid_blocks = 0;
  if (!grid_blocks) {
    int dev = 0, cus = 0, per_cu = 0;
    hipGetDevice(&dev);
    hipDeviceGetAttribute(&cus, hipDeviceAttributeMultiprocessorCount, dev);
    hipOccupancyMaxActiveBlocksPerMultiprocessor(&per_cu, mega, 256, 0);
    if (per_cu > 2) per_cu = 2;
    if (per_cu < 1) per_cu = 1;
    grid_blocks = cus * per_cu;
  }
  Params p{};
  const float** pin = (const float**)&p;
  for (int i = 0; i < 25; ++i) pin[i] = (const float*)d_in[i];
  p.out = (float*)d_out;
  p.ws = (char*)d_ws;
  if (WS_NEED > ws_size) { fprintf(stderr, "workspace too small: need %zu have %zu\n", (size_t)WS_NEED, ws_size); return; }
  (void)hipMemsetAsync((char*)d_ws + O_BAR, 0, 16384, stream);
  void* args[] = {&p};
  hipError_t e = hipLaunchCooperativeKernel((void*)mega, dim3(grid_blocks), dim3(256), args, 0, stream);
  if (e != hipSuccess) fprintf(stderr, "cooperative launch failed: %s (grid %d)\n", hipGetErrorString(e), grid_blocks);
}
```

```cpp
#include <hip/hip_runtime.h>
#include <hip/hip_cooperative_groups.h>
#include <cstdio>
namespace cg = cooperative_groups;

typedef unsigned short u16;
typedef __attribute__((ext_vector_type(8))) short bf16x8;
typedef __attribute__((ext_vector_type(4))) short s16x4;
typedef __attribute__((ext_vector_type(16))) float f32x16;
typedef __attribute__((ext_vector_type(2))) __bf16 bf2_t;
typedef __attribute__((ext_vector_type(4))) unsigned u32x4;

#define DI __device__ __forceinline__
#define MFMA32(a, b, c) __builtin_amdgcn_mfma_f32_32x32x16_bf16((a), (b), (c), 0, 0, 0)

constexpr int D = 1024;
constexpr int DIN = 8384;
constexpr int UC = 5312;
constexpr int TG = 8192;
constexpr int KVROWS = 9216;
constexpr int C_CQ = 0, C_CKV = 384, C_KPE = 640, C_GA = 672, C_B = 1184, C_C = 1696, C_X = 2208, C_GB = 2720,
              C_Q = 3232, C_K = 3744, C_V = 4256, C_Z = 4768, C_AB = 5280, C_MG = 5312;
constexpr int LDS_MAIN = 73728;
constexpr int LDS_TOTAL = LDS_MAIN + 4096;
constexpr size_t OUT_CKV = 25165824, OUT_KPE = 29360128, OUT_ST = 29884416;

struct Params {
  const float *x_prompt, *x_sample, *c, *cache_ckv, *cache_kpe, *state_gdn, *c_ctx, *norm_g, *w_ada, *b_ada, *w_in,
      *q_norm_g, *kv_norm_g, *w_uq, *w_ukv, *conv_b_w, *conv_qkv_w, *a_log, *dt_bias, *gdn_norm_g, *w_pa, *w_pb, *w_pc,
      *w_o, *final_norm_g;
  float* out;
  char* ws;
};
constexpr size_t al256(size_t x) { return (x + 255) & ~(size_t)255; }
constexpr size_t O_WT1 = 0;
constexpr size_t O_WUQ = O_WT1 + al256((size_t)DIN * 1024 * 2);
constexpr size_t O_WUKVF = O_WUQ + al256((size_t)768 * 384 * 2);
constexpr size_t O_WUKV = O_WUKVF + al256((size_t)1024 * 256 * 2);
constexpr size_t O_WPA = O_WUKV + al256((size_t)1024 * 256 * 2);
constexpr size_t O_WPB = O_WPA + al256((size_t)1024 * 512 * 2);
constexpr size_t O_WPC = O_WPB + al256((size_t)1024 * 512 * 2);
constexpr size_t O_WO = O_WPC + al256((size_t)1024 * 512 * 2);
constexpr size_t O_MOD = O_WO + al256((size_t)1024 * 1024 * 2);
constexpr size_t O_H = O_MOD + al256((size_t)5 * 2 * 9 * 3072 * 4);
constexpr size_t O_U = O_H + al256((size_t)TG * 1024 * 2);
constexpr size_t O_GAB = O_U + al256((size_t)TG * UC * 2);
constexpr size_t O_Q = O_GAB + al256((size_t)TG * 32 * 4);
constexpr size_t O_KV = O_Q + al256((size_t)TG * 768 * 2);
constexpr size_t O_KR = O_KV + al256((size_t)KVROWS * 1024 * 2);
constexpr size_t O_CKVC = O_KR + al256((size_t)KVROWS * 32 * 2);
constexpr size_t O_GD = O_CKVC + al256((size_t)1024 * 256 * 2);
constexpr size_t O_OF = O_GD + al256((size_t)2 * 128 * 8 * 16384 * 2);
constexpr size_t O_OR = O_OF + al256((size_t)TG * 512 * 2);
constexpr size_t O_BAR = O_OR + al256((size_t)TG * 512 * 2);
constexpr size_t WS_NEED = O_BAR + 16384;
#define WSP(T, name, off) DI T* name(const Params& P) { return (T*)(P.ws + (off)); }
WSP(u16, pWT1, O_WT1) WSP(u16, pWUQ, O_WUQ) WSP(u16, pWUKVF, O_WUKVF) WSP(u16, pWUKV, O_WUKV) WSP(u16, pWPA, O_WPA)
WSP(u16, pWPB, O_WPB) WSP(u16, pWPC, O_WPC) WSP(u16, pWO, O_WO) WSP(float, pMOD, O_MOD) WSP(u16, pH, O_H) WSP(u16, pU, O_U)
WSP(float, pGAB, O_GAB) WSP(u16, pQ, O_Q) WSP(u16, pKV, O_KV) WSP(u16, pKR, O_KR) WSP(u16, pCKVC, O_CKVC) WSP(u16, pGD, O_GD)
WSP(u16, pOF, O_OF) WSP(u16, pOR, O_OR) WSP(float, pMF, O_GD)

struct Grp { int tok0, nseq, seqlen, latent, seq0, nchunk, kvlen; };
DI Grp make_grp(int g) {
  Grp r;
  if (g == 0) { r.tok0 = 0; r.nseq = 32; r.seqlen = 256; r.latent = 0; r.seq0 = 0; r.kvlen = 256; }
  else { r.tok0 = 8192 * g; r.nseq = 4; r.seqlen = 2048; r.latent = 1; r.seq0 = (g - 1) * 4; r.kvlen = 2304; }
  r.nchunk = r.seqlen / 64;
  return r;
}

DI int otid() { int t = __builtin_amdgcn_workitem_id_x(); asm volatile("" : "+v"(t)); return t; }
DI unsigned pk2(float a, float b) { bf2_t v; v[0] = (__bf16)a; v[1] = (__bf16)b; return __builtin_bit_cast(unsigned, v); }
DI u16 f2bf(float a) { return __builtin_bit_cast(u16, (__bf16)a); }
DI float bf2f(u16 x) { return __uint_as_float(((unsigned)x) << 16); }
DI float bflo(unsigned w) { return __uint_as_float(w << 16); }
DI float bfhi(unsigned w) { return __uint_as_float(w & 0xffff0000u); }
DI void unpack8(uint4 w, float* v) {
  v[0] = bflo(w.x); v[1] = bfhi(w.x); v[2] = bflo(w.y); v[3] = bfhi(w.y);
  v[4] = bflo(w.z); v[5] = bfhi(w.z); v[6] = bflo(w.w); v[7] = bfhi(w.w);
}
DI uint4 pack8(const float* v) { return make_uint4(pk2(v[0], v[1]), pk2(v[2], v[3]), pk2(v[4], v[5]), pk2(v[6], v[7])); }
DI float silu_f(float x) { return x / (1.f + __expf(-x)); }
DI float sigmoid_f(float x) { return 1.f / (1.f + __expf(-x)); }
DI int crow(int i, int h) { return (i & 3) + 8 * (i >> 2) + 4 * h; }
DI int swap23(int k) { return (k & ~12) | ((k & 4) << 1) | ((k & 8) >> 1); }
DI float wave_sum(float v) {
  v += __shfl_xor(v, 32); v += __shfl_xor(v, 16); v += __shfl_xor(v, 8);
  v += __shfl_xor(v, 4); v += __shfl_xor(v, 2); v += __shfl_xor(v, 1);
  return v;
}
DI bf16x8 pack_frag(const f32x16& x, int s) {
  uint4 p = make_uint4(pk2(x[8 * s], x[8 * s + 1]), pk2(x[8 * s + 2], x[8 * s + 3]), pk2(x[8 * s + 4], x[8 * s + 5]),
                       pk2(x[8 * s + 6], x[8 * s + 7]));
  return __builtin_bit_cast(bf16x8, p);
}
DI f32x16 zero16() { f32x16 z; for (int i = 0; i < 16; ++i) z[i] = 0.f; return z; }
DI void rope8(float* v, int pi0, int tpos) {
#pragma unroll
  for (int j = 0; j < 4; ++j) {
    int pi = pi0 + j;
    int f = pi & 7;
    float pos = (float)((pi < 8) ? (tpos >> 6) : (tpos & 63));
    float ang = pos * __builtin_amdgcn_exp2f(-(float)f * 1.6609640474436813f);
    float cs = __cosf(ang), sn = __sinf(ang);
    float x0 = v[2 * j], x1 = v[2 * j + 1];
    v[2 * j] = x0 * cs - x1 * sn;
    v[2 * j + 1] = x0 * sn + x1 * cs;
  }
}

DI void mod_item(const Params& P, int it, float* lds) {
  const int kq4 = it & 3, cg = (it >> 2) % 48, l = it / 192;
  const int c0 = cg * 64;
  int tid = otid();
  float* sc = lds;
  for (int i = tid; i < 9 * 256; i += 256) {
    int b = i >> 8, k = kq4 * 256 + (i & 255);
    float cv = (b == 0) ? P.c_ctx[k] : P.c[(b - 1) * 1024 + k];
    sc[i] = silu_f(cv);
  }
  __syncthreads();
  int col = tid & 63, kq = tid >> 6;
  float acc[9];
#pragma unroll
  for (int b = 0; b < 9; ++b) acc[b] = 0.f;
  const float* w = P.w_ada + (size_t)l * 1024 * 3072 + (size_t)(kq4 * 256 + kq * 64) * 3072 + c0 + col;
#pragma unroll 8
  for (int k = 0; k < 64; ++k) {
    float wv = w[(size_t)k * 3072];
#pragma unroll
    for (int b = 0; b < 9; ++b) acc[b] += sc[b * 256 + kq * 64 + k] * wv;
  }
  float* red = lds + 9 * 256;
#pragma unroll
  for (int b = 0; b < 9; ++b) red[(kq * 9 + b) * 64 + col] = acc[b];
  __syncthreads();
  for (int i = tid; i < 9 * 64; i += 256) {
    int b = i >> 6, cc = i & 63;
    float s = red[(0 * 9 + b) * 64 + cc] + red[(1 * 9 + b) * 64 + cc] + red[(2 * 9 + b) * 64 + cc] + red[(3 * 9 + b) * 64 + cc];
    if (kq4 == 0) s += P.b_ada[l * 3072 + c0 + cc];
    pMOD(P)[(size_t)kq4 * 55296 + (l * 9 + b) * 3072 + c0 + cc] = s;
  }
  __syncthreads();
}
DI float4 mod4(const float* p) {
  float4 a = *(const float4*)p, b = *(const float4*)(p + 55296), c = *(const float4*)(p + 2 * 55296), d = *(const float4*)(p + 3 * 55296);
  return make_float4(a.x + b.x + c.x + d.x, a.y + b.y + c.y + d.y, a.z + b.z + c.z + d.z, a.w + b.w + c.w + d.w);
}

DI void convT_tile(const float* __restrict__ src, int K, int N, u16* __restrict__ dst, const float* __restrict__ g, int tk, int tn, float* lds) {
  int tid = otid();
  int k0 = tk * 64, n0 = tn * 64;
  for (int i = tid; i < 4096; i += 256) {
    int kk = i >> 6, nn = i & 63;
    float v = src[(size_t)(k0 + kk) * N + n0 + nn];
    if (g) v *= g[k0 + kk];
    lds[kk * 65 + nn] = v;
  }
  __syncthreads();
  for (int i = tid; i < 512; i += 256) {
    int nn = i >> 3, kc = (i & 7) * 8;
    float v[8];
#pragma unroll
    for (int j = 0; j < 8; ++j) v[j] = lds[(kc + j) * 65 + nn];
    *(uint4*)&dst[(size_t)(n0 + nn) * K + k0 + kc] = pack8(v);
  }
  __syncthreads();
}

DI void convert_phase(const Params& P, int l, float* lds) {
  for (int it = blockIdx.x; it < 2936; it += gridDim.x) {
    int i = it;
    if (i < 2096) { convT_tile(P.w_in + (size_t)l * 1024 * DIN, 1024, DIN, pWT1(P), nullptr, i % 16, i / 16, lds); continue; }
    i -= 2096;
    if (i < 72) { convT_tile(P.w_uq + (size_t)l * 384 * 768, 384, 768, pWUQ(P), P.q_norm_g + l * 384, i % 6, i / 6, lds); continue; }
    i -= 72;
    if (i < 64) { convT_tile(P.w_ukv + (size_t)l * 256 * 1024, 256, 1024, pWUKVF(P), P.kv_norm_g + l * 256, i % 4, i / 4, lds); continue; }
    i -= 64;
    if (i < 64) { convT_tile(P.w_ukv + (size_t)l * 256 * 1024, 256, 1024, pWUKV(P), nullptr, i % 4, i / 4, lds); continue; }
    i -= 64;
    if (i < 128) { convT_tile(P.w_pa + (size_t)l * 512 * 1024, 512, 1024, pWPA(P), nullptr, i % 8, i / 8, lds); continue; }
    i -= 128;
    if (i < 128) { convT_tile(P.w_pb + (size_t)l * 512 * 1024, 512, 1024, pWPB(P), nullptr, i % 8, i / 8, lds); continue; }
    i -= 128;
    if (i < 128) { convT_tile(P.w_pc + (size_t)l * 512 * 1024, 512, 1024, pWPC(P), nullptr, i % 8, i / 8, lds); continue; }
    i -= 128;
    convT_tile(P.w_o + (size_t)l * 1024 * 1024, 1024, 1024, pWO(P), nullptr, i % 16, i / 16, lds);
  }
}

DI const float* x_row(const Params& P, int l, int tok) {
  if (l == 0) return (tok < 8192) ? P.x_prompt + (size_t)tok * 1024 : P.x_sample + (size_t)(tok - 8192) * 1024;
  return P.out + (size_t)tok * 1024;
}
DI void norm_phase(const Params& P, const Grp& G, int l, bool first = false) {
  int wave = (blockIdx.x * 256 + otid()) >> 6, lane = otid() & 63, nw = gridDim.x * 4;
  const float* ng = P.norm_g + l * 1024;
  for (int r = wave; r < TG; r += nw) {
    int tok = G.tok0 + r;
    const float* xr = x_row(P, l, tok);
    int cond = G.latent ? 1 + G.seq0 + (r >> 11) : 0;
    const float* mod = pMOD(P) + (l * 9 + cond) * 3072;
    float4 v[4];
    float ss = 0.f;
#pragma unroll
    for (int i = 0; i < 4; ++i) {
      v[i] = *(const float4*)(xr + i * 256 + lane * 4);
      ss += v[i].x * v[i].x + v[i].y * v[i].y + v[i].z * v[i].z + v[i].w * v[i].w;
    }
    ss = wave_sum(ss);
    float rstd = rsqrtf(ss * (1.f / 1024.f) + 1e-6f);
#pragma unroll
    for (int i = 0; i < 4; ++i) {
      int col = i * 256 + lane * 4;
      float4 gg = *(const float4*)(ng + col);
      float4 sh = first ? mod4(mod + col) : *(const float4*)(mod + 4 * 55296 + col);
      float4 scl = first ? mod4(mod + 1024 + col) : *(const float4*)(mod + 4 * 55296 + 1024 + col);
      float h0 = v[i].x * rstd * gg.x * (1.f + scl.x) + sh.x;
      float h1 = v[i].y * rstd * gg.y * (1.f + scl.y) + sh.y;
      float h2 = v[i].z * rstd * gg.z * (1.f + scl.z) + sh.z;
      float h3 = v[i].w * rstd * gg.w * (1.f + scl.w) + sh.w;
      *(uint2*)&pH(P)[(size_t)r * 1024 + col] = make_uint2(pk2(h0, h1), pk2(h2, h3));
    }
  }
  if (G.latent) {
    int gt = blockIdx.x * 256 + otid(), nth = gridDim.x * 256;
    for (int i = gt; i < 1024 * 256; i += nth) {
      int row = i >> 8, cc = i & 255;
      int sl = row >> 8, p = row & 255;
      pCKVC(P)[i] = f2bf(P.cache_ckv[(((size_t)(G.seq0 + sl) * 2 + l) * 256 + p) * 256 + cc]);
    }
    for (int i = gt; i < 1024 * 32; i += nth) {
      int row = i >> 5, cc = i & 31;
      int sl = row >> 8, p = row & 255;
      pKR(P)[((size_t)sl * 2304 + p) * 32 + cc] = f2bf(P.cache_kpe[(((size_t)(G.seq0 + sl) * 2 + l) * 256 + p) * 32 + cc]);
    }
  }
}

DI void g_load(u32x4 (&ra)[4], u32x4 (&rb)[4], const u16* ga, const u16* gb, size_t sa32, size_t sb32, int kt) {
#pragma unroll
  for (int i = 0; i < 4; ++i) {
    ra[i] = *(const u32x4*)(ga + i * sa32 + kt * 64);
    rb[i] = *(const u32x4*)(gb + i * sb32 + kt * 64);
  }
}
DI void l_store(const u32x4 (&ra)[4], const u32x4 (&rb)[4], u16* dA, u16* dB, int lrow, int lcol) {
#pragma unroll
  for (int i = 0; i < 4; ++i) {
    *(u32x4*)&dA[(lrow + 32 * i) * 72 + lcol] = ra[i];
    *(u32x4*)&dB[(lrow + 32 * i) * 72 + lcol] = rb[i];
  }
}
DI void t_compute(const u16* cA, const u16* cB, f32x16 (&acc)[2][2]) {
#pragma unroll
  for (int s = 0; s < 4; ++s) {
    bf16x8 a0 = *(const bf16x8*)(cA + s * 16);
    bf16x8 a1 = *(const bf16x8*)(cA + 32 * 72 + s * 16);
    bf16x8 b0 = *(const bf16x8*)(cB + s * 16);
    bf16x8 b1 = *(const bf16x8*)(cB + 32 * 72 + s * 16);
    acc[0][0] = MFMA32(a0, b0, acc[0][0]);
    acc[0][1] = MFMA32(a0, b1, acc[0][1]);
    acc[1][0] = MFMA32(a1, b0, acc[1][0]);
    acc[1][1] = MFMA32(a1, b1, acc[1][1]);
  }
}
DI void gemm_mainloop(const u16* __restrict__ A, int lda, const u16* __restrict__ B, int ldb, int K, u16* lds, f32x16 (&acc)[2][2]) {
  const int tid = otid(), lane = tid & 63, w = tid >> 6, wr = w >> 1, wc = w & 1, r = lane & 31, h = lane >> 5;
  u16* sA = lds;
  u16* sB = lds + 2 * 128 * 72;
  const int lrow = tid >> 3, lcol = (tid & 7) * 8;
  const u16* ga = A + (size_t)lrow * lda + lcol;
  const u16* gb = B + (size_t)lrow * ldb + lcol;
  const size_t sa32 = (size_t)32 * lda, sb32 = (size_t)32 * ldb;
  u32x4 ra0[4], rb0[4], ra1[4], rb1[4];
  const int nk = K >> 6;
  const u16* cA = sA + (wr * 64 + r) * 72 + h * 8;
  const u16* cB = sB + (wc * 64 + r) * 72 + h * 8;
  g_load(ra0, rb0, ga, gb, sa32, sb32, 0);
  g_load(ra1, rb1, ga, gb, sa32, sb32, 1);
  l_store(ra0, rb0, sA, sB, lrow, lcol);
  __syncthreads();
  for (int kt = 0; kt < nk; kt += 2) {
    if (kt + 2 < nk) g_load(ra0, rb0, ga, gb, sa32, sb32, kt + 2);
    t_compute(cA, cB, acc);
    l_store(ra1, rb1, sA + 128 * 72, sB + 128 * 72, lrow, lcol);
    __syncthreads();
    if (kt + 3 < nk) g_load(ra1, rb1, ga, gb, sa32, sb32, kt + 3);
    t_compute(cA + 128 * 72, cB + 128 * 72, acc);
    if (kt + 2 < nk) l_store(ra0, rb0, sA, sB, lrow, lcol);
    __syncthreads();
  }
}

DI void gemm_mainloop1(const u16* __restrict__ A, int lda, const u16* __restrict__ B, int ldb, int K, u16* lds, f32x16 (&acc)[2][2]) {
  const int tid = otid(), lane = tid & 63, w = tid >> 6, wr = w >> 1, wc = w & 1, r = lane & 31, h = lane >> 5;
  u16* sA = lds;
  u16* sB = lds + 2 * 128 * 72;
  const int lrow = tid >> 3, lcol = (tid & 7) * 8;
  const u16* ga = A + (size_t)lrow * lda + lcol;
  const u16* gb = B + (size_t)lrow * ldb + lcol;
  const size_t sa32 = (size_t)32 * lda, sb32 = (size_t)32 * ldb;
  u32x4 ra[4], rb[4];
  const int nk = K >> 6;
  const u16* cA = sA + (wr * 64 + r) * 72 + h * 8;
  const u16* cB = sB + (wc * 64 + r) * 72 + h * 8;
  g_load(ra, rb, ga, gb, sa32, sb32, 0);
  l_store(ra, rb, sA, sB, lrow, lcol);
  __syncthreads();
  for (int kt = 0; kt < nk; ++kt) {
    const int cur = kt & 1;
    if (kt + 1 < nk) g_load(ra, rb, ga, gb, sa32, sb32, kt + 1);
    t_compute(cA + cur * 128 * 72, cB + cur * 128 * 72, acc);
    if (kt + 1 < nk) l_store(ra, rb, sA + (cur ^ 1) * 128 * 72, sB + (cur ^ 1) * 128 * 72, lrow, lcol);
    __syncthreads();
  }
}

template <int UNR = 2, class F>
DI void gemm_epilogue(f32x16 (&acc)[2][2], float* cs, F f) {
  const int tid = otid(), lane = tid & 63, w = tid >> 6, wr = w >> 1, wc = w & 1, r = lane & 31, h = lane >> 5;
#pragma unroll
  for (int mt = 0; mt < 2; ++mt)
#pragma unroll
    for (int nt = 0; nt < 2; ++nt)
#pragma unroll
      for (int i = 0; i < 16; ++i) cs[(wr * 64 + mt * 32 + crow(i, h)) * 132 + wc * 64 + nt * 32 + r] = acc[mt][nt][i];
  __syncthreads();
#pragma unroll UNR
  for (int it = 0; it < 8; ++it) {
    int c = tid + 256 * it;
    int row = c >> 4, col = (c & 15) * 8;
    float v[8];
    float4 a = *(const float4*)&cs[row * 132 + col];
    float4 b = *(const float4*)&cs[row * 132 + col + 4];
    v[0] = a.x; v[1] = a.y; v[2] = a.z; v[3] = a.w; v[4] = b.x; v[5] = b.y; v[6] = b.z; v[7] = b.w;
    f(row, col, v);
  }
  __syncthreads();
}

DI void stagger() { if (blockIdx.x >= (gridDim.x >> 1)) __builtin_amdgcn_s_sleep(24); }
DI void gemm1_tile(const Params& P, const Grp& G, int l, int mtile, int ntile, char* ldsraw) {
  u16* lds = (u16*)ldsraw;
  {
    const int m0 = mtile * 128, n0 = ntile * 128;
    f32x16 acc[2][2];
    acc[0][0] = zero16(); acc[0][1] = zero16(); acc[1][0] = zero16(); acc[1][1] = zero16();
    gemm_mainloop(pH(P) + (size_t)m0 * 1024, 1024, pWT1(P) + (size_t)n0 * 1024, 1024, 1024, lds, acc);
    gemm_epilogue(acc, (float*)ldsraw, [&](int row, int col, float* v) {
      int n = n0 + col;
      if (n >= UC) return;
      int lt = m0 + row;
      *(uint4*)&pU(P)[(size_t)lt * UC + n] = pack8(v);
      if (n >= C_KPE && n < C_KPE + 32) {
        int cc = n - C_KPE;
        int sl = lt / G.seqlen, tpos = lt % G.seqlen;
        if (!G.latent) {
          float* dst = P.out + OUT_KPE + (((size_t)sl * 2 + l) * 256 + tpos) * 32 + cc;
          *(float4*)dst = make_float4(v[0], v[1], v[2], v[3]);
          *(float4*)(dst + 4) = make_float4(v[4], v[5], v[6], v[7]);
          *(uint4*)&pKR(P)[(size_t)lt * 32 + cc] = pack8(v);
        } else {
          rope8(v, cc >> 1, tpos);
          *(uint4*)&pKR(P)[((size_t)sl * 2304 + 256 + tpos) * 32 + cc] = pack8(v);
        }
      } else if (n >= C_AB) {
        float* dst = pGAB(P) + (size_t)lt * 32 + (n - C_AB);
        *(float4*)dst = make_float4(v[0], v[1], v[2], v[3]);
        *(float4*)(dst + 4) = make_float4(v[4], v[5], v[6], v[7]);
      }
    });
  }
}
DI void gemm1_phase(const Params& P, const Grp& G, int l, char* ldsraw) {
  for (int it = blockIdx.x; it < 64 * 40; it += gridDim.x) {
    int xcd = it & 7, j = it >> 3;
    int sj = j / 40, q = j % 40;
    int S = xcd + 8 * sj;
    int mtile = (S & 7) * 8 + (q & 7), nidx = (S >> 3) * 5 + (q >> 3);
    gemm1_tile(P, G, l, mtile, nidx < 6 ? nidx : nidx + 2, ldsraw);
  }
}

DI void rowstat(const u16* __restrict__ A, int lda, int K, float* rs) {
  int tid = otid();
  int row = tid >> 1, half = tid & 1;
  const u16* p = A + (size_t)row * lda + half * (K >> 1);
  float ss = 0.f;
  for (int c = 0; c < (K >> 4); ++c) {
    float v[8];
    unpack8(*(const uint4*)(p + c * 8), v);
#pragma unroll
    for (int j = 0; j < 8; ++j) ss += v[j] * v[j];
  }
  ss += __shfl_xor(ss, 1);
  if (half == 0) rs[row] = rsqrtf(ss / (float)K + 1e-6f);
  __syncthreads();
}

DI void qproj_tile(const Params& P, const Grp& G, int it, char* ldsraw) {
  u16* lds = (u16*)ldsraw;
  float* rs = (float*)(ldsraw + LDS_MAIN);
  int mtile = it / 6, ntile = it % 6;
  int m0 = mtile * 128, n0 = ntile * 128;
  const u16* A = pU(P) + (size_t)m0 * UC + C_CQ;
  rowstat(A, UC, 384, rs);
  f32x16 acc[2][2];
  acc[0][0] = zero16(); acc[0][1] = zero16(); acc[1][0] = zero16(); acc[1][1] = zero16();
  gemm_mainloop(A, UC, pWUQ(P) + (size_t)n0 * 384, 384, 384, lds, acc);
  gemm_epilogue(acc, (float*)ldsraw, [&](int row, int col, float* v) {
    int n = n0 + col, lt = m0 + row;
    float s = rs[row];
#pragma unroll
    for (int j = 0; j < 8; ++j) v[j] *= s;
    int d = n % 96;
    if (G.latent && d >= 64) rope8(v, (d - 64) >> 1, lt & 2047);
    *(uint4*)&pQ(P)[(size_t)lt * 768 + n] = pack8(v);
  });
}

DI void kvexp_tile(const Params& P, const Grp& G, int l, int it, char* ldsraw) {
  u16* lds = (u16*)ldsraw;
  float* rs = (float*)(ldsraw + LDS_MAIN);
  int mtile = it >> 3, ntile = it & 7;
  int n0 = ntile * 128;
  const bool cache = mtile >= 64;
  int m0 = (cache ? (mtile - 64) : mtile) * 128;
  const u16* A;
  int lda;
  const u16* W;
  if (!cache) {
    A = pU(P) + (size_t)m0 * UC + C_CKV; lda = UC; W = pWUKVF(P);
    rowstat(A, UC, 256, rs);
  } else {
    A = pCKVC(P) + (size_t)m0 * 256; lda = 256; W = pWUKV(P);
    if (otid() < 128) rs[otid()] = 1.f;
    __syncthreads();
  }
  f32x16 acc[2][2];
  acc[0][0] = zero16(); acc[0][1] = zero16(); acc[1][0] = zero16(); acc[1][1] = zero16();
  gemm_mainloop(A, lda, W + (size_t)n0 * 256, 256, 256, lds, acc);
  gemm_epilogue(acc, (float*)ldsraw, [&](int row, int col, float* v) {
    int n = n0 + col, lr = m0 + row;
    float s = rs[row];
#pragma unroll
    for (int j = 0; j < 8; ++j) v[j] *= s;
    size_t kvrow;
    if (!G.latent) kvrow = lr;
    else if (!cache) kvrow = (size_t)(lr >> 11) * 2304 + 256 + (lr & 2047);
    else kvrow = (size_t)(lr >> 8) * 2304 + (lr & 255);
    *(uint4*)&pKV(P)[kvrow * 1024 + n] = pack8(v);
  });
  if (!G.latent && ntile == 0) {
    const float* kg = P.kv_norm_g + l * 256;
    for (int c = otid(); c < 128 * 32; c += 256) {
      int row = c >> 5, c8 = (c & 31) * 8;
      int lt = m0 + row;
      float v[8];
      unpack8(*(const uint4*)&pU(P)[(size_t)lt * UC + C_CKV + c8], v);
      float s = rs[row];
      float* dst = P.out + OUT_CKV + (((size_t)(lt >> 8) * 2 + l) * 256 + (lt & 255)) * 256 + c8;
      *(float4*)dst = make_float4(v[0] * s * kg[c8], v[1] * s * kg[c8 + 1], v[2] * s * kg[c8 + 2], v[3] * s * kg[c8 + 3]);
      *(float4*)(dst + 4) = make_float4(v[4] * s * kg[c8 + 4], v[5] * s * kg[c8 + 5], v[6] * s * kg[c8 + 6], v[7] * s * kg[c8 + 7]);
    }
    __syncthreads();
  }
}

DI f32x16 mm64_tile(const u16* A, const u16* Bt, int tm, int tn, int r, int h) {
  f32x16 acc = zero16();
  const u16* pa = A + (32 * tm + r) * 72 + 8 * h;
  const u16* pb = Bt + (32 * tn + r) * 72 + 8 * h;
#pragma unroll
  for (int s = 0; s < 4; ++s) acc = MFMA32(*(const bf16x8*)(pa + 16 * s), *(const bf16x8*)(pb + 16 * s), acc);
  return acc;
}

DI void gdn_prep_item(const Params& P, const Grp& G, int l, int it, char* ldsraw) {
  const int tid0 = otid();
  int t2 = it;
  const int N = G.nchunk;
  const int ctok = t2 % N; t2 /= N;
  const int head = t2 & 7, sl = t2 >> 3;
  u16* lds = (u16*)ldsraw;
  u16* Kn = lds;
  u16* Qn = lds + 4608;
  u16* VTb = lds + 9216;
  u16* KTb = lds + 13824;
  u16* KdT = lds + 18432;
  u16* AT = lds + 23040;
  float* Lf = (float*)(lds + 27648);
  float* sm = (float*)(ldsraw + LDS_MAIN);
  float* s_gc = sm; float* s_beta = sm + 64; float* s_eg = sm + 128; float* s_ekd = sm + 192;

  unsigned yp[3][8];
  {
    const int i = tid0 >> 2, part = tid0 & 3;
    const int tpos = ctok * 64 + i;
    const size_t lt = (size_t)sl * G.seqlen + tpos;
#pragma unroll
    for (int m = 0; m < 3; ++m) {
      const int cb = C_Q + m * 512 + head * 64 + part * 16;
      const float* cw = P.conv_qkv_w + (size_t)l * 3 * 1536 + m * 512 + head * 64 + part * 16;
      float y[16];
#pragma unroll
      for (int hf = 0; hf < 2; ++hf) {
        float xc[8], xm[8], xp[8];
        unpack8(*(const uint4*)&pU(P)[lt * UC + cb + hf * 8], xc);
        if (tpos > 0) unpack8(*(const uint4*)&pU(P)[(lt - 1) * UC + cb + hf * 8], xm);
        else { for (int j = 0; j < 8; ++j) xm[j] = 0.f; }
        if (tpos < G.seqlen - 1) unpack8(*(const uint4*)&pU(P)[(lt + 1) * UC + cb + hf * 8], xp);
        else { for (int j = 0; j < 8; ++j) xp[j] = 0.f; }
        float w0[8], w1[8], w2[8];
        *(float4*)&w0[0] = *(const float4*)(cw + hf * 8); *(float4*)&w0[4] = *(const float4*)(cw + hf * 8 + 4);
        *(float4*)&w1[0] = *(const float4*)(cw + 1536 + hf * 8); *(float4*)&w1[4] = *(const float4*)(cw + 1536 + hf * 8 + 4);
        *(float4*)&w2[0] = *(const float4*)(cw + 3072 + hf * 8); *(float4*)&w2[4] = *(const float4*)(cw + 3072 + hf * 8 + 4);
#pragma unroll
        for (int j = 0; j < 8; ++j) y[hf * 8 + j] = silu_f(xm[j] * w0[j] + xc[j] * w1[j] + xp[j] * w2[j]);
      }
      if (m < 2) {
        float sq = 0.f;
#pragma unroll
        for (int j = 0; j < 16; ++j) sq += y[j] * y[j];
        sq += __shfl_xor(sq, 1); sq += __shfl_xor(sq, 2);
        float iq = rsqrtf(sq + 1e-6f) * ((m == 0) ? 0.125f : 1.f);
#pragma unroll
        for (int j = 0; j < 16; ++j) y[j] *= iq;
      }
#pragma unroll
      for (int j = 0; j < 8; ++j) yp[m][j] = pk2(y[2 * j], y[2 * j + 1]);
    }
  }
  int ndir = 2;
  asm volatile("" : "+s"(ndir));
  for (int dir = 0; dir < ndir; ++dir) {
  const int tid = otid(), lane = tid & 63, w = tid >> 6, r = lane & 31, h = lane >> 5;
  const int i = tid >> 2, part = tid & 3;
  if (tid < 64) {
    const int ti = tid;
    const int tp = dir ? (ctok * 64 + 63 - ti) : (ctok * 64 + ti);
    const size_t ltg = (size_t)sl * G.seqlen + tp;
    float a = pGAB(P)[ltg * 32 + dir * 8 + head];
    float b = pGAB(P)[ltg * 32 + 16 + dir * 8 + head];
    float xs = a + P.dt_bias[l * 16 + dir * 8 + head];
    float sp = (xs > 20.f) ? xs : log1pf(__expf(xs));
    float g = -__expf(P.a_log[l * 16 + dir * 8 + head]) * sp;
#pragma unroll
    for (int off = 1; off < 64; off <<= 1) {
      float t = __shfl_up(g, off);
      if (ti >= off) g += t;
    }
    float gl = __shfl(g, 63);
    s_gc[ti] = g; s_beta[ti] = sigmoid_f(b); s_eg[ti] = __expf(g); s_ekd[ti] = __expf(gl - g);
  }
  __syncthreads();
  {
    const int ri = dir ? (63 - i) : i;
    const float be = s_beta[ri], eg = s_eg[ri], ekd = s_ekd[ri];
    *(uint4*)&Qn[ri * 72 + part * 16] = make_uint4(yp[0][0], yp[0][1], yp[0][2], yp[0][3]);
    *(uint4*)&Qn[ri * 72 + part * 16 + 8] = make_uint4(yp[0][4], yp[0][5], yp[0][6], yp[0][7]);
    *(uint4*)&Kn[ri * 72 + part * 16] = make_uint4(yp[1][0], yp[1][1], yp[1][2], yp[1][3]);
    *(uint4*)&Kn[ri * 72 + part * 16 + 8] = make_uint4(yp[1][4], yp[1][5], yp[1][6], yp[1][7]);
#pragma unroll
    for (int j = 0; j < 8; ++j) {
      const int cc = part * 16 + 2 * j;
      const float k0 = bflo(yp[1][j]), k1 = bfhi(yp[1][j]), v0 = bflo(yp[2][j]), v1 = bfhi(yp[2][j]);
      KTb[cc * 72 + ri] = f2bf(k0 * be * eg);  KTb[(cc + 1) * 72 + ri] = f2bf(k1 * be * eg);
      KdT[cc * 72 + ri] = f2bf(k0 * ekd);      KdT[(cc + 1) * 72 + ri] = f2bf(k1 * ekd);
      VTb[cc * 72 + ri] = f2bf(v0 * be);       VTb[(cc + 1) * 72 + ri] = f2bf(v1 * be);
    }
  }
  __syncthreads();
  const int tm = w >> 1, tn = w & 1;
  {
    f32x16 aK = mm64_tile(Kn, Kn, tm, tn, r, h);
    f32x16 aQ = mm64_tile(Qn, Kn, tm, tn, r, h);
    const int jj = 32 * tn + r;
    const float gcj = s_gc[jj];
#pragma unroll
    for (int ii = 0; ii < 16; ++ii) {
      const int ri = 32 * tm + crow(ii, h);
      float dec = (ri >= jj) ? __expf(s_gc[ri] - gcj) : 0.f;
      Lf[ri * 72 + jj] = (ri > jj) ? s_beta[ri] * aK[ii] * dec : 0.f;
      AT[ri * 72 + jj] = f2bf(aQ[ii] * dec);
    }
  }
  __syncthreads();
  float* Pf = (float*)Kn;
  if (w == 0) {
    const int b = lane >> 4, c = lane & 15;
    float t[16];
#pragma unroll
    for (int a = 0; a < 16; ++a) {
      float s = (a == c) ? 1.f : 0.f;
#pragma unroll
      for (int j = 0; j < a; ++j) s -= Lf[(16 * b + a) * 72 + 16 * b + j] * t[j];
      t[a] = s;
    }
#pragma unroll
    for (int a = 0; a < 16; ++a) Lf[(16 * b + a) * 72 + 16 * b + c] = t[a];
  }
  __syncthreads();
  for (int idx = tid; idx < 512; idx += 256) {
    const int p = idx >> 8, a = (idx >> 4) & 15, j = idx & 15;
    float s = 0.f;
#pragma unroll
    for (int k = 0; k < 16; ++k) s += Lf[(32 * p + 16 + a) * 72 + 32 * p + k] * Lf[(32 * p + k) * 72 + 32 * p + j];
    Pf[p * 256 + a * 16 + j] = s;
  }
  __syncthreads();
  for (int idx = tid; idx < 512; idx += 256) {
    const int p = idx >> 8, a = (idx >> 4) & 15, j = idx & 15;
    float s = 0.f;
#pragma unroll
    for (int k = 0; k < 16; ++k) s += Lf[(32 * p + 16 + a) * 72 + 32 * p + 16 + k] * Pf[p * 256 + k * 16 + j];
    Lf[(32 * p + 16 + a) * 72 + 32 * p + j] = -s;
  }
  __syncthreads();
  if (w == 0) {
    f32x16 acc = zero16();
#pragma unroll
    for (int s2 = 0; s2 < 16; ++s2)
      acc = __builtin_amdgcn_mfma_f32_32x32x2f32(Lf[(32 + r) * 72 + 2 * s2 + h], Lf[(2 * s2 + h) * 72 + r], acc, 0, 0, 0);
#pragma unroll
    for (int ii = 0; ii < 16; ++ii) Pf[crow(ii, h) * 32 + r] = acc[ii];
  }
  __syncthreads();
  if (w == 0) {
    f32x16 acc = zero16();
#pragma unroll
    for (int s2 = 0; s2 < 16; ++s2)
      acc = __builtin_amdgcn_mfma_f32_32x32x2f32(Lf[(32 + r) * 72 + 32 + 2 * s2 + h], Pf[(2 * s2 + h) * 32 + r], acc, 0, 0, 0);
#pragma unroll
    for (int ii = 0; ii < 16; ++ii) Lf[(32 + crow(ii, h)) * 72 + r] = -acc[ii];
  }
  __syncthreads();
  u16* Tb = Kn;
  for (int idx = tid; idx < 4096; idx += 256) {
    const int a = idx >> 6, j = idx & 63;
    Tb[a * 72 + j] = f2bf(Lf[a * 72 + j]);
  }
  __syncthreads();
  u16* UT = (u16*)Lf;
  u16* WT = UT + 4608;
  {
    f32x16 aU = mm64_tile(Tb, VTb, tm, tn, r, h);
    f32x16 aW = mm64_tile(Tb, KTb, tm, tn, r, h);
    __syncthreads();
#pragma unroll
    for (int g4 = 0; g4 < 4; ++g4) {
      const int ci = 32 * tm + 8 * g4 + 4 * h;
      *(uint2*)&UT[(32 * tn + r) * 72 + ci] = make_uint2(pk2(aU[4 * g4], aU[4 * g4 + 1]), pk2(aU[4 * g4 + 2], aU[4 * g4 + 3]));
      *(uint2*)&WT[(32 * tn + r) * 72 + ci] = make_uint2(pk2(aW[4 * g4], aW[4 * g4 + 1]), pk2(aW[4 * g4 + 2], aW[4 * g4 + 3]));
    }
  }
  __syncthreads();
  {
    const int cdir = dir ? (N - 1 - ctok) : ctok;
    u16* gd = pGD(P) + ((((size_t)dir * G.nseq + sl) * 8 + head) * N + cdir) * 16384;
    f32x16 a1 = mm64_tile(AT, WT, tm, tn, r, h);
    f32x16 a3 = mm64_tile(KdT, WT, tm, tn, r, h);
    const int cc = 32 * tn + r;
    const int pc = swap23(cc);
    const float egl = s_eg[63];
#pragma unroll
    for (int ii = 0; ii < 16; ++ii) {
      const int ri = 32 * tm + crow(ii, h);
      float qe = bf2f(Qn[ri * 72 + cc]) * s_eg[ri] - a1[ii];
      float mc = ((ri == cc) ? egl : 0.f) - a3[ii];
      gd[ri * 64 + pc] = f2bf(qe);
      gd[4096 + ri * 64 + pc] = f2bf(mc);
    }
    f32x16 a2 = mm64_tile(AT, UT, tm, tn, r, h);
    f32x16 a4 = mm64_tile(KdT, UT, tm, tn, r, h);
    u16* o3 = gd + 3 * 4096 + ((tm * 2 + tn) * 64 + lane) * 16;
    u16* o2 = gd + 2 * 4096 + ((tm * 2 + tn) * 64 + lane) * 16;
    *(uint4*)o3 = make_uint4(pk2(a2[0], a2[1]), pk2(a2[2], a2[3]), pk2(a2[4], a2[5]), pk2(a2[6], a2[7]));
    *(uint4*)(o3 + 8) = make_uint4(pk2(a2[8], a2[9]), pk2(a2[10], a2[11]), pk2(a2[12], a2[13]), pk2(a2[14], a2[15]));
    *(uint4*)o2 = make_uint4(pk2(a4[0], a4[1]), pk2(a4[2], a4[3]), pk2(a4[4], a4[5]), pk2(a4[6], a4[7]));
    *(uint4*)(o2 + 8) = make_uint4(pk2(a4[8], a4[9]), pk2(a4[10], a4[11]), pk2(a4[12], a4[13]), pk2(a4[14], a4[15]));
  }
  __syncthreads();
  }
}

DI f32x16 unpack16(const u16* p) {
  uint4 a = *(const uint4*)p, b = *(const uint4*)(p + 8);
  f32x16 v;
  v[0] = bflo(a.x); v[1] = bfhi(a.x); v[2] = bflo(a.y); v[3] = bfhi(a.y); v[4] = bflo(a.z); v[5] = bfhi(a.z); v[6] = bflo(a.w); v[7] = bfhi(a.w);
  v[8] = bflo(b.x); v[9] = bfhi(b.x); v[10] = bflo(b.y); v[11] = bfhi(b.y); v[12] = bflo(b.z); v[13] = bfhi(b.z); v[14] = bflo(b.w); v[15] = bfhi(b.w);
  return v;
}

struct ScanOps { bf16x8 qa[2][4], ma[2][4]; u32x4 bc[2][2], ou[2][2]; };
DI void scan_load(ScanOps& o, const u16* mb, int r, int h, int nt, int lane) {
#pragma unroll
  for (int mt = 0; mt < 2; ++mt) {
#pragma unroll
    for (int ks = 0; ks < 4; ++ks) {
      o.qa[mt][ks] = *(const bf16x8*)(mb + (32 * mt + r) * 64 + 16 * ks + 8 * h);
      o.ma[mt][ks] = *(const bf16x8*)(mb + 4096 + (32 * mt + r) * 64 + 16 * ks + 8 * h);
    }
    const u16* pb = mb + 2 * 4096 + ((mt * 2 + nt) * 64 + lane) * 16;
    const u16* po = mb + 3 * 4096 + ((mt * 2 + nt) * 64 + lane) * 16;
    o.bc[mt][0] = *(const u32x4*)pb; o.bc[mt][1] = *(const u32x4*)(pb + 8);
    o.ou[mt][0] = *(const u32x4*)po; o.ou[mt][1] = *(const u32x4*)(po + 8);
  }
}
DI f32x16 unpack16v(u32x4 a, u32x4 b) {
  f32x16 v;
  v[0] = bflo(a[0]); v[1] = bfhi(a[0]); v[2] = bflo(a[1]); v[3] = bfhi(a[1]); v[4] = bflo(a[2]); v[5] = bfhi(a[2]); v[6] = bflo(a[3]); v[7] = bfhi(a[3]);
  v[8] = bflo(b[0]); v[9] = bfhi(b[0]); v[10] = bflo(b[1]); v[11] = bfhi(b[1]); v[12] = bflo(b[2]); v[13] = bfhi(b[2]); v[14] = bflo(b[3]); v[15] = bfhi(b[3]);
  return v;
}
DI void scan_step(const ScanOps& o, f32x16 (&S)[2], u16* obuf, size_t rowbase, int ctok, int dir, int colbase, int h) {
  f32x16 ov[2], Sn[2];
#pragma unroll
  for (int mt = 0; mt < 2; ++mt) {
    Sn[mt] = unpack16v(o.bc[mt][0], o.bc[mt][1]);
    ov[mt] = unpack16v(o.ou[mt][0], o.ou[mt][1]);
  }
  bf16x8 Sb[4];
  Sb[0] = pack_frag(S[0], 0); Sb[1] = pack_frag(S[0], 1); Sb[2] = pack_frag(S[1], 0); Sb[3] = pack_frag(S[1], 1);
#pragma unroll
  for (int mt = 0; mt < 2; ++mt)
#pragma unroll
    for (int ks = 0; ks < 4; ++ks) {
      ov[mt] = MFMA32(o.qa[mt][ks], Sb[ks], ov[mt]);
      Sn[mt] = MFMA32(o.ma[mt][ks], Sb[ks], Sn[mt]);
    }
#pragma unroll
  for (int mt = 0; mt < 2; ++mt)
#pragma unroll
    for (int ii = 0; ii < 16; ++ii) {
      int ri = 32 * mt + crow(ii, h);
      int tpos = dir ? (ctok * 64 + 63 - ri) : (ctok * 64 + ri);
      obuf[(rowbase + tpos) * 512 + colbase] = f2bf(ov[mt][ii]);
    }
  S[0] = Sn[0]; S[1] = Sn[1];
}

DI void gdn_scan_item(const Params& P, const Grp& G, int l, int it) {
  const int tid = otid(), lane = tid & 63, w = tid >> 6, r = lane & 31, h = lane >> 5;
  const int head = it & 7, sl = it >> 3;
  const int dir = w >> 1, nt = w & 1;
  const int N = G.nchunk;
  f32x16 S[2];
  if (G.latent) {
    const float* st = P.state_gdn + ((((size_t)(G.seq0 + sl) * 2 + l) * 2 + dir) * 8 + head) * 4096;
#pragma unroll
    for (int mt = 0; mt < 2; ++mt)
#pragma unroll
      for (int ii = 0; ii < 16; ++ii) S[mt][ii] = st[(32 * mt + crow(ii, h)) * 64 + 32 * nt + r];
  } else { S[0] = zero16(); S[1] = zero16(); }
  const u16* base = pGD(P) + ((((size_t)dir * G.nseq + sl) * 8 + head) * N) * 16384;
  u16* obuf = dir ? pOR(P) : pOF(P);
  const size_t rowbase = (size_t)sl * G.seqlen;
  const int colbase = head * 64 + 32 * nt + r;
  ScanOps oa;
  for (int c = 0; c < N; ++c) {
    scan_load(oa, base + (size_t)c * 16384, r, h, nt, lane);
    scan_step(oa, S, obuf, rowbase, dir ? (N - 1 - c) : c, dir, colbase, h);
  }
  if (!G.latent) {
    float* st = P.out + OUT_ST + ((((size_t)sl * 2 + l) * 2 + dir) * 8 + head) * 4096;
#pragma unroll
    for (int mt = 0; mt < 2; ++mt)
#pragma unroll
      for (int ii = 0; ii < 16; ++ii) st[(32 * mt + crow(ii, h)) * 64 + 32 * nt + r] = S[mt][ii];
  }
  asm volatile("s_waitcnt vmcnt(0)" ::: "memory");
  __syncthreads();
  const float* gn = P.gdn_norm_g + l * 64;
#pragma unroll 4
  for (int idx = tid; idx < G.seqlen * 8; idx += 256) {
    int tpos = idx >> 3, part = idx & 7;
    size_t lt = (size_t)sl * G.seqlen + tpos;
    float a[8], b[8], z[8];
    unpack8(*(const uint4*)&pOF(P)[lt * 512 + head * 64 + part * 8], a);
    unpack8(*(const uint4*)&pOR(P)[lt * 512 + head * 64 + part * 8], b);
    u16* zp = &pU(P)[lt * UC + C_Z + head * 64 + part * 8];
    unpack8(*(const uint4*)zp, z);
    float ss = 0.f;
#pragma unroll
    for (int j = 0; j < 8; ++j) { a[j] += b[j]; ss += a[j] * a[j]; }
    ss += __shfl_xor(ss, 1); ss += __shfl_xor(ss, 2); ss += __shfl_xor(ss, 4);
    float rstd = rsqrtf(ss * (1.f / 64.f) + 1e-6f);
#pragma unroll
    for (int j = 0; j < 8; ++j) a[j] = a[j] * rstd * gn[part * 8 + j] * silu_f(z[j]);
    *(uint4*)zp = pack8(a);
  }
  __syncthreads();
}

struct KvRegs { u32x4 k[2], kr, v[2]; };
DI void attn_gload(KvRegs& g, const u16* kvp, const u16* krp, size_t row0, int tid, int head) {
#pragma unroll
  for (int i2 = 0; i2 < 2; ++i2) {
    int c = tid + 256 * i2;
    int key = c >> 3, d8 = (c & 7) * 8;
    const u16* src = &kvp[(row0 + key) * 1024 + head * 128 + d8];
    g.k[i2] = *(const u32x4*)src;
    g.v[i2] = *(const u32x4*)(src + 64);
  }
  g.kr = *(const u32x4*)&krp[(row0 + (tid >> 2)) * 32 + (tid & 3) * 8];
}
DI void attn_lstore(const KvRegs& g, u16* Kl, u16* Vt, int tid) {
#pragma unroll
  for (int i2 = 0; i2 < 2; ++i2) {
    int c = tid + 256 * i2;
    int key = c >> 3, d8 = (c & 7) * 8;
    *(u32x4*)&Kl[key * 104 + d8] = g.k[i2];
    u32x4 vv = g.v[i2];
    u16* vd = &Vt[d8 * 72 + key];
    vd[0] = (u16)(vv[0] & 0xffff); vd[72] = (u16)(vv[0] >> 16); vd[144] = (u16)(vv[1] & 0xffff); vd[216] = (u16)(vv[1] >> 16);
    vd[288] = (u16)(vv[2] & 0xffff); vd[360] = (u16)(vv[2] >> 16); vd[432] = (u16)(vv[3] & 0xffff); vd[504] = (u16)(vv[3] >> 16);
  }
  *(u32x4*)&Kl[(tid >> 2) * 104 + 64 + (tid & 3) * 8] = g.kr;
}
DI void attn_tile(const u16* Kl, const u16* Vt, const bf16x8 (&qf)[6], f32x16 (&O)[2], float& mrun, float& lrun, int r, int h) {
  const float sc = 0.14724455f;
  f32x16 st[2];
#pragma unroll
  for (int mt = 0; mt < 2; ++mt) {
    st[mt] = zero16();
#pragma unroll
    for (int s = 0; s < 6; ++s) st[mt] = MFMA32(*(const bf16x8*)&Kl[(32 * mt + r) * 104 + 16 * s + 8 * h], qf[s], st[mt]);
  }
  float mloc = -1e30f;
#pragma unroll
  for (int mt = 0; mt < 2; ++mt)
#pragma unroll
    for (int ii = 0; ii < 16; ++ii) { st[mt][ii] *= sc; mloc = fmaxf(mloc, st[mt][ii]); }
  mloc = fmaxf(mloc, __shfl_xor(mloc, 32));
  const float mnew = fmaxf(mrun, mloc);
  const float alpha = __builtin_amdgcn_exp2f(mrun - mnew);
  mrun = mnew;
  float ps = 0.f;
#pragma unroll
  for (int mt = 0; mt < 2; ++mt)
#pragma unroll
    for (int ii = 0; ii < 16; ++ii) { float p = __builtin_amdgcn_exp2f(st[mt][ii] - mnew); st[mt][ii] = p; ps += p; }
  lrun = lrun * alpha + ps;
#pragma unroll
  for (int ii = 0; ii < 16; ++ii) { O[0][ii] *= alpha; O[1][ii] *= alpha; }
#pragma unroll
  for (int mt = 0; mt < 2; ++mt)
#pragma unroll
    for (int s2 = 0; s2 < 2; ++s2) {
      bf16x8 pb = pack_frag(st[mt], s2);
#pragma unroll
      for (int dvt = 0; dvt < 2; ++dvt) {
        const u16* vp = &Vt[(32 * dvt + r) * 72 + 32 * mt + 16 * s2 + 4 * h];
        s16x4 lo = *(const s16x4*)vp;
        s16x4 hi = *(const s16x4*)(vp + 8);
        bf16x8 va = __builtin_shufflevector(lo, hi, 0, 1, 2, 3, 4, 5, 6, 7);
        O[dvt] = MFMA32(va, pb, O[dvt]);
      }
    }
}

DI void attn_item(const Params& P, const Grp& G, int it, char* ldsraw) {
  const int tid = otid(), lane = tid & 63, w = tid >> 6, r = lane & 31, h = lane >> 5;
  const int nqb = G.seqlen >> 7;
  const int qb = it % nqb, head = (it / nqb) & 7, sl = it / (nqb * 8);
  u16* Kl0 = (u16*)ldsraw;
  u16* Vt0 = Kl0 + 64 * 104;
  u16* Kl1 = Vt0 + 64 * 72;
  u16* Vt1 = Kl1 + 64 * 104;
  const size_t ltq = (size_t)sl * G.seqlen + qb * 128 + w * 32 + r;
  bf16x8 qf[6];
#pragma unroll
  for (int s = 0; s < 6; ++s) qf[s] = *(const bf16x8*)&pQ(P)[ltq * 768 + head * 96 + s * 16 + h * 8];
  const int nkt = G.kvlen >> 6;
  const size_t kvbase = (size_t)sl * G.kvlen;
  const u16* kvp = pKV(P);
  const u16* krp = pKR(P);
  float mrun = -1e30f, lrun = 0.f;
  f32x16 O[2];
  O[0] = zero16(); O[1] = zero16();
  KvRegs g0, g1;
  attn_gload(g0, kvp, krp, kvbase, tid, head);
  attn_gload(g1, kvp, krp, kvbase + 64, tid, head);
  __syncthreads();
  attn_lstore(g0, Kl0, Vt0, tid);
  __syncthreads();
  for (int kt = 0; kt < nkt; kt += 2) {
    if (kt + 2 < nkt) attn_gload(g0, kvp, krp, kvbase + (size_t)(kt + 2) * 64, tid, head);
    attn_tile(Kl0, Vt0, qf, O, mrun, lrun, r, h);
    attn_lstore(g1, Kl1, Vt1, tid);
    __syncthreads();
    if (kt + 3 < nkt) attn_gload(g1, kvp, krp, kvbase + (size_t)(kt + 3) * 64, tid, head);
    attn_tile(Kl1, Vt1, qf, O, mrun, lrun, r, h);
    if (kt + 2 < nkt) attn_lstore(g0, Kl0, Vt0, tid);
    __syncthreads();
  }
  const float ltot = lrun + __shfl_xor(lrun, 32);
  const float inv = 1.f / ltot;
#pragma unroll
  for (int dvt = 0; dvt < 2; ++dvt)
#pragma unroll
    for (int g4 = 0; g4 < 4; ++g4) {
      u16* gp = &pU(P)[ltq * UC + C_GA + head * 64 + 32 * dvt + 8 * g4 + 4 * h];
      uint2 gw = *(const uint2*)gp;
      float o0 = O[dvt][4 * g4] * inv * silu_f(bflo(gw.x));
      float o1 = O[dvt][4 * g4 + 1] * inv * silu_f(bfhi(gw.x));
      float o2 = O[dvt][4 * g4 + 2] * inv * silu_f(bflo(gw.y));
      float o3 = O[dvt][4 * g4 + 3] * inv * silu_f(bfhi(gw.y));
      *(uint2*)gp = make_uint2(pk2(o0, o1), pk2(o2, o3));
    }
}

DI void convb_item(const Params& P, const Grp& G, int l, int it) {
  const int tid = otid();
  const float* cw = P.conv_b_w + (size_t)l * 3 * 512;
  for (int rep = 0; rep < 16; ++rep) {
    int c = tid + 256 * rep;
    int row = c >> 6, c8 = (c & 63) * 8;
    size_t lt = (size_t)it * 64 + row;
    int tpos = (int)(lt % G.seqlen);
    float cc[8], xx[8], pm[8], p0[8], pp[8], bb[8], gg[8];
    unpack8(*(const uint4*)&pU(P)[lt * UC + C_C + c8], cc);
    unpack8(*(const uint4*)&pU(P)[lt * UC + C_X + c8], xx);
#pragma unroll
    for (int j = 0; j < 8; ++j) p0[j] = cc[j] * xx[j];
    if (tpos > 0) {
      unpack8(*(const uint4*)&pU(P)[(lt - 1) * UC + C_C + c8], cc);
      unpack8(*(const uint4*)&pU(P)[(lt - 1) * UC + C_X + c8], xx);
#pragma unroll
      for (int j = 0; j < 8; ++j) pm[j] = cc[j] * xx[j];
    } else { for (int j = 0; j < 8; ++j) pm[j] = 0.f; }
    if (tpos < G.seqlen - 1) {
      unpack8(*(const uint4*)&pU(P)[(lt + 1) * UC + C_C + c8], cc);
      unpack8(*(const uint4*)&pU(P)[(lt + 1) * UC + C_X + c8], xx);
#pragma unroll
      for (int j = 0; j < 8; ++j) pp[j] = cc[j] * xx[j];
    } else { for (int j = 0; j < 8; ++j) pp[j] = 0.f; }
    unpack8(*(const uint4*)&pU(P)[lt * UC + C_B + c8], bb);
    u16* gp = &pU(P)[lt * UC + C_GB + c8];
    unpack8(*(const uint4*)gp, gg);
    float o[8];
#pragma unroll
    for (int j = 0; j < 8; ++j)
      o[j] = bb[j] * (pm[j] * cw[c8 + j] + p0[j] * cw[512 + c8 + j] + pp[j] * cw[1024 + c8 + j]) * silu_f(gg[j]);
    *(uint4*)gp = pack8(o);
  }
}

DI void merge_tile(const Params& P, int it, char* ldsraw) {
  u16* lds = (u16*)ldsraw;
  const int mtile = (it & 7) * 8 + ((it >> 3) & 7), ntile = it >> 6;
  const int m0 = mtile * 128, n0 = ntile * 128;
  u16* Mb = pKV(P);
  unsigned mp[2][2][8];
#pragma unroll 1
  for (int br = 0; br < 3; ++br) {
    f32x16 acc[2][2];
    acc[0][0] = zero16(); acc[0][1] = zero16(); acc[1][0] = zero16(); acc[1][1] = zero16();
    gemm_mainloop(pH(P) + (size_t)m0 * 1024, 1024, pWT1(P) + (size_t)(C_MG + br * 1024 + n0) * 1024, 1024, 1024, lds, acc);
    unsigned sg[2][2][4];
#pragma unroll
    for (int a2 = 0; a2 < 2; ++a2)
#pragma unroll
      for (int b2 = 0; b2 < 2; ++b2)
#pragma unroll
        for (int i = 0; i < 4; ++i) {
          unsigned q0 = (unsigned)(sigmoid_f(acc[a2][b2][4 * i]) * 255.f + 0.5f), q1 = (unsigned)(sigmoid_f(acc[a2][b2][4 * i + 1]) * 255.f + 0.5f);
          unsigned q2 = (unsigned)(sigmoid_f(acc[a2][b2][4 * i + 2]) * 255.f + 0.5f), q3 = (unsigned)(sigmoid_f(acc[a2][b2][4 * i + 3]) * 255.f + 0.5f);
          sg[a2][b2][i] = q0 | (q1 << 8) | (q2 << 16) | (q3 << 24);
        }
    acc[0][0] = zero16(); acc[0][1] = zero16(); acc[1][0] = zero16(); acc[1][1] = zero16();
    const int ocol = (br == 0) ? C_GA : (br == 1 ? C_GB : C_Z);
    const u16* Wp = (br == 0) ? pWPA(P) : (br == 1 ? pWPB(P) : pWPC(P));
    gemm_mainloop1(pU(P) + (size_t)m0 * UC + ocol, UC, Wp + (size_t)n0 * 512, 512, 512, lds, acc);
#pragma unroll
    for (int a2 = 0; a2 < 2; ++a2)
#pragma unroll
      for (int b2 = 0; b2 < 2; ++b2)
#pragma unroll
        for (int i = 0; i < 4; ++i) {
          const unsigned wq = sg[a2][b2][i];
          acc[a2][b2][4 * i] *= (float)(wq & 255u) * (1.f / 255.f);
          acc[a2][b2][4 * i + 1] *= (float)((wq >> 8) & 255u) * (1.f / 255.f);
          acc[a2][b2][4 * i + 2] *= (float)((wq >> 16) & 255u) * (1.f / 255.f);
          acc[a2][b2][4 * i + 3] *= (float)(wq >> 24) * (1.f / 255.f);
        }
    if (br < 2) {
#pragma unroll
      for (int a2 = 0; a2 < 2; ++a2)
#pragma unroll
        for (int b2 = 0; b2 < 2; ++b2)
#pragma unroll
          for (int i = 0; i < 8; ++i) {
            float lo = acc[a2][b2][2 * i], hi = acc[a2][b2][2 * i + 1];
            if (br > 0) { lo += bflo(mp[a2][b2][i]); hi += bfhi(mp[a2][b2][i]); }
            mp[a2][b2][i] = pk2(lo, hi);
          }
    } else {
#pragma unroll
      for (int a2 = 0; a2 < 2; ++a2)
#pragma unroll
        for (int b2 = 0; b2 < 2; ++b2)
#pragma unroll
          for (int i = 0; i < 8; ++i) { acc[a2][b2][2 * i] += bflo(mp[a2][b2][i]); acc[a2][b2][2 * i + 1] += bfhi(mp[a2][b2][i]); }
      gemm_epilogue(acc, (float*)ldsraw, [&](int row, int col, float* v) {
        *(uint4*)&Mb[(size_t)(m0 + row) * 1024 + n0 + col] = pack8(v);
      });
    }
  }
}

DI void out_tile(const Params& P, const Grp& G, int l, int it, char* ldsraw) {
  u16* lds = (u16*)ldsraw;
  const int mtile = (it & 7) * 8 + ((it >> 3) & 7), ntile = it >> 6;
  const int m0 = mtile * 128, n0 = ntile * 128;
  f32x16 acc[2][2];
  acc[0][0] = zero16(); acc[0][1] = zero16(); acc[1][0] = zero16(); acc[1][1] = zero16();
  gemm_mainloop(pKV(P) + (size_t)m0 * 1024, 1024, pWO(P) + (size_t)n0 * 1024, 1024, 1024, lds, acc);
  gemm_epilogue<4>(acc, (float*)ldsraw, [&](int row, int col, float* v) {
    int lt = m0 + row, n = n0 + col;
    int tok = G.tok0 + lt;
    int cond = G.latent ? 1 + G.seq0 + (lt >> 11) : 0;
    const float* gate = pMOD(P) + (l * 9 + cond) * 3072 + 2048 + n;
    const float* xr = x_row(P, l, tok) + n;
    float4 x0 = *(const float4*)xr, x1 = *(const float4*)(xr + 4);
    float4 g0 = *(const float4*)(gate + 4 * 55296), g1 = *(const float4*)(gate + 4 * 55296 + 4);
    float* dst = P.out + (size_t)tok * 1024 + n;
    *(float4*)dst = make_float4(x0.x + g0.x * v[0], x0.y + g0.y * v[1], x0.z + g0.z * v[2], x0.w + g0.w * v[3]);
    *(float4*)(dst + 4) = make_float4(x1.x + g1.x * v[4], x1.y + g1.y * v[5], x1.z + g1.z * v[6], x1.w + g1.w * v[7]);
  });
}

DI void final_norm_phase(const Params& P) {
  int wave = (blockIdx.x * 256 + otid()) >> 6, lane = otid() & 63, nw = gridDim.x * 4;
  for (int r = wave; r < 24576; r += nw) {
    float* xr = P.out + (size_t)r * 1024;
    float4 v[4];
    float ss = 0.f;
#pragma unroll
    for (int i = 0; i < 4; ++i) {
      v[i] = *(const float4*)(xr + i * 256 + lane * 4);
      ss += v[i].x * v[i].x + v[i].y * v[i].y + v[i].z * v[i].z + v[i].w * v[i].w;
    }
    ss = wave_sum(ss);
    float rstd = rsqrtf(ss * (1.f / 1024.f) + 1e-6f);
#pragma unroll
    for (int i = 0; i < 4; ++i) {
      int col = i * 256 + lane * 4;
      float4 gg = *(const float4*)(P.final_norm_g + col);
      *(float4*)(xr + col) = make_float4(v[i].x * rstd * gg.x, v[i].y * rstd * gg.y, v[i].z * rstd * gg.z, v[i].w * rstd * gg.w);
    }
  }
}

#define XB_TMO      128
#define XB_XCNT(j)  (256  + 64 * (j))
#define XB_XSUB(j)  (1280 + 64 * (j))
#define XB_XGEN(j)  (2304 + 64 * (j))
#define XB_TOP      3328
#define XB_TOPGEN   3392
#define XCD_BAR_WORDS 3456
#define XB_SPIN_CAP (1u << 18)
#define LAS __attribute__((address_space(3)))

__device__ __forceinline__ unsigned xb_ld(unsigned* p)              { return __hip_atomic_load(p, __ATOMIC_RELAXED, __HIP_MEMORY_SCOPE_AGENT); }
__device__ __forceinline__ unsigned xb_add(unsigned* p, unsigned v) { return __hip_atomic_fetch_add(p, v, __ATOMIC_RELAXED, __HIP_MEMORY_SCOPE_AGENT); }
__device__ __forceinline__ unsigned xb_xcc_id() { return (unsigned)__builtin_amdgcn_s_getreg((3 << 11) | 20) & 0xFu; }
#define XB_SPIN(cond, bar) do { unsigned _sp = 0; while (cond) { __builtin_amdgcn_s_sleep(1); \
    if ((++_sp & 255u) == 0u) { if (xb_ld(&(bar)[XB_TMO])) break; if (_sp > XB_SPIN_CAP) { atomicAdd(&(bar)[XB_TMO], 1u); break; } } } } while (0)

struct XcdBarrier {
    unsigned* bar; unsigned x;
    volatile LAS unsigned* st;
};

__device__ __forceinline__ XcdBarrier xcd_barrier_post(unsigned* bar, volatile LAS unsigned* st) {
    XcdBarrier b; b.bar = bar; b.x = xb_xcc_id(); b.st = st;
    if (threadIdx.x == 0) (void)xb_add(&bar[XB_XCNT(b.x)], 1u);
    return b;
}
__device__ __forceinline__ void xcd_barrier_complete(unsigned* bar, unsigned x, unsigned& nloc, unsigned& nx) {
    const unsigned G = gridDim.x * gridDim.y * gridDim.z;
    unsigned sum, cnt, mine, sp = 0u;
    for (;;) {
        sum = 0u; cnt = 0u; mine = 0u;
#pragma unroll
        for (unsigned j = 0; j < 16; ++j) { const unsigned c = xb_ld(&bar[XB_XCNT(j)]); sum += c; cnt += (c > 0u) ? 1u : 0u; mine = (j == x) ? c : mine; }
        if (sum == G) break;
        __builtin_amdgcn_s_sleep(1);
        if ((++sp & 255u) == 0u) { if (xb_ld(&bar[XB_TMO])) break; if (sp > XB_SPIN_CAP) { atomicAdd(&bar[XB_TMO], 1u); break; } }
    }
    nloc = mine > 0u ? mine : 1u; nx = cnt > 0u ? cnt : 1u;
}

__device__ __forceinline__ void xcd_barrier(const XcdBarrier& b) {
    asm volatile("s_waitcnt vmcnt(0)" ::: "memory");
    __syncthreads();
    if (threadIdx.x == 0) {
        unsigned* bar = b.bar;
        __builtin_amdgcn_s_waitcnt(0);
        unsigned nloc = b.st[0], nx = b.st[1];
        if (nloc == 0u) { xcd_barrier_complete(bar, b.x, nloc, nx); b.st[0] = nloc; b.st[1] = nx; }
        const unsigned old = xb_add(&bar[XB_XSUB(b.x)], 1u);
        const unsigned gen = old / nloc;
        if (old + 1u == (gen + 1u) * nloc) {
            __builtin_amdgcn_fence(__ATOMIC_RELEASE, "agent");
            asm volatile("s_waitcnt vmcnt(0)" ::: "memory");
            const unsigned og = xb_add(&bar[XB_TOP], 1u);
            const unsigned tg = og / nx;
            if (og + 1u == (tg + 1u) * nx) xb_add(&bar[XB_TOPGEN], 1u);
            else XB_SPIN(xb_ld(&bar[XB_TOPGEN]) == tg, bar);
            __builtin_amdgcn_fence(__ATOMIC_ACQUIRE, "agent");
            xb_add(&bar[XB_XGEN(b.x)], 1u);
            asm volatile("s_waitcnt vmcnt(0)" ::: "memory");
        } else {
            XB_SPIN(xb_ld(&bar[XB_XGEN(b.x)]) == gen, bar);
            __builtin_amdgcn_fence(__ATOMIC_ACQUIRE, "agent");
            asm volatile("s_waitcnt vmcnt(0)" ::: "memory");
        }
    }
    __syncthreads();
}

#ifndef PROBE
#define PROBE 0
#endif
#define GSYNC() do { xcd_barrier(xb); if (PROBE & 1) xcd_barrier(xb); } while (0)
__global__ void __launch_bounds__(256, 2) mega(Params P) {
  cg::grid_group grid = cg::this_grid();
  __shared__ __attribute__((aligned(16))) char lds[LDS_TOTAL];
  __shared__ __attribute__((aligned(16))) unsigned xb_words[4];
  __shared__ int s_item;
  if (threadIdx.x < 4) xb_words[threadIdx.x] = 0u;
  __syncthreads();
  const XcdBarrier xb = xcd_barrier_post((unsigned*)(P.ws + O_BAR), (volatile LAS unsigned*)xb_words);
  if (P.out == nullptr) grid.sync();
  for (int it = blockIdx.x; it < 384; it += gridDim.x) mod_item(P, it, (float*)lds);
  convert_phase(P, 0, (float*)lds);
  GSYNC();
  norm_phase(P, make_grp(0), 0, true);
  GSYNC();
  for (int l = 0; l < 2; ++l) {
    if (l == 1) { convert_phase(P, 1, (float*)lds); norm_phase(P, make_grp(0), 1); GSYNC(); }
    for (int g = 0; g < 3; ++g) {
      const Grp G = make_grp(g);
      if (l == 0 && g == 0) {
        float* md = pMOD(P);
        for (int i = blockIdx.x * 256 + threadIdx.x; i < 55296; i += gridDim.x * 256)
          md[4 * 55296 + i] = md[i] + md[55296 + i] + md[2 * 55296 + i] + md[3 * 55296 + i];
      }
      for (int rep = 0; rep < ((PROBE & 2) ? 2 : 1); ++rep) gemm1_phase(P, G, l, lds);
      GSYNC();
      for (int rep = 0; rep < ((PROBE & 4) ? 2 : 1); ++rep) {
        const int nq = 64 * 6, nkv = (G.latent ? 72 : 64) * 8, ngd = 128 * 8, nx = 128;
        for (int it = blockIdx.x; it < nq + nkv + ngd + nx; it += gridDim.x) {
          if (it < ngd) gdn_prep_item(P, G, l, it, lds);
          else if (it < ngd + nx) { const int e = it - ngd; gemm1_tile(P, G, l, e >> 1, 6 + (e & 1), lds); }
          else if (it < ngd + nx + nkv) kvexp_tile(P, G, l, it - ngd - nx, lds);
          else qproj_tile(P, G, it - ngd - nx - nkv, lds);
        }
      }
      GSYNC();
      {
        const int nsc = G.nseq * 8, nat = 512, ncv = 128;
        unsigned* ctr = (unsigned*)(P.ws + O_BAR) + (l * 3 + g);
        bool first_item = true;
        for (;;) {
          int it;
          if (first_item) { it = blockIdx.x; first_item = false; }
          else {
            __syncthreads();
            if (threadIdx.x == 0) s_item = (int)(gridDim.x + atomicAdd(ctr, 1u));
            __syncthreads();
            it = s_item;
          }
          if (it >= nsc + nat + ncv) break;
          if (it < nsc) gdn_scan_item(P, G, l, it);
          else if (it < nsc + nat) attn_item(P, G, it - nsc, lds);
          else convb_item(P, G, l, it - nsc - nat);
        }
      }
      GSYNC();
      stagger();
      for (int rep = 0; rep < ((PROBE & 8) ? 2 : 1); ++rep)
        for (int it = blockIdx.x; it < 512; it += gridDim.x) merge_tile(P, it, lds);
      GSYNC();
      for (int it = blockIdx.x; it < 512; it += gridDim.x) out_tile(P, G, l, it, lds);
      if (g < 2) norm_phase(P, make_grp(g + 1), l);
      GSYNC();
    }
  }
  final_norm_phase(P);
}

extern "C" void kernel_launch(void* const* d_in, const int* in_sizes, int n_in, void* d_out, int out_size,
                              void* d_ws, size_t ws_size, hipStream_t stream) {
  static int grid_blocks = 0;
  if (!grid_blocks) {
    int dev = 0, cus = 0, per_cu = 0;
    hipGetDevice(&dev);
    hipDeviceGetAttribute(&cus, hipDeviceAttributeMultiprocessorCount, dev);
    hipOccupancyMaxActiveBlocksPerMultiprocessor(&per_cu, mega, 256, 0);
    if (per_cu > 2) per_cu = 2;
    if (per_cu < 1) per_cu = 1;
    grid_blocks = cus * per_cu;
  }
  Params p{};
  const float** pin = (const float**)&p;
  for (int i = 0; i < 25; ++i) pin[i] = (const float*)d_in[i];
  p.out = (float*)d_out;
  p.ws = (char*)d_ws;
  if (WS_NEED > ws_size) { fprintf(stderr, "workspace too small: need %zu have %zu\n", (size_t)WS_NEED, ws_size); return; }
  (void)hipMemsetAsync((char*)d_ws + O_BAR, 0, 16384, stream);
  void* args[] = {&p};
  hipError_t e = hipLaunchCooperativeKernel((void*)mega, dim3(grid_blocks), dim3(256), args, 0, stream);
  if (e != hipSuccess) fprintf(stderr, "cooperative launch failed: %s (grid %d)\n", hipGetErrorString(e), grid_blocks);
}
```

```cpp
#include <hip/hip_runtime.h>
#include <hip/hip_cooperative_groups.h>
#include <cstdio>
namespace cg = cooperative_groups;

typedef unsigned short u16;
typedef __attribute__((ext_vector_type(8))) short bf16x8;
typedef __attribute__((ext_vector_type(4))) short s16x4;
typedef __attribute__((ext_vector_type(16))) float f32x16;
typedef __attribute__((ext_vector_type(2))) __bf16 bf2_t;
typedef __attribute__((ext_vector_type(4))) unsigned u32x4;

#define DI __device__ __forceinline__
#define MFMA32(a, b, c) __builtin_amdgcn_mfma_f32_32x32x16_bf16((a), (b), (c), 0, 0, 0)

constexpr int D = 1024;
constexpr int DIN = 8384;
constexpr int UC = 5312;
constexpr int TG = 8192;
constexpr int KVROWS = 9216;
constexpr int C_CQ = 0, C_CKV = 384, C_KPE = 640, C_GA = 672, C_B = 1184, C_C = 1696, C_X = 2208, C_GB = 2720,
              C_Q = 3232, C_K = 3744, C_V = 4256, C_Z = 4768, C_AB = 5280, C_MG = 5312;
constexpr int LDS_MAIN = 73728;
constexpr int LDS_TOTAL = LDS_MAIN + 4096;
constexpr size_t OUT_CKV = 25165824, OUT_KPE = 29360128, OUT_ST = 29884416;

struct Params {
  const float *x_prompt, *x_sample, *c, *cache_ckv, *cache_kpe, *state_gdn, *c_ctx, *norm_g, *w_ada, *b_ada, *w_in,
      *q_norm_g, *kv_norm_g, *w_uq, *w_ukv, *conv_b_w, *conv_qkv_w, *a_log, *dt_bias, *gdn_norm_g, *w_pa, *w_pb, *w_pc,
      *w_o, *final_norm_g;
  float* out;
  char* ws;
};
constexpr size_t al256(size_t x) { return (x + 255) & ~(size_t)255; }
constexpr size_t O_WT1 = 0;
constexpr size_t O_WUQ = O_WT1 + al256((size_t)DIN * 1024 * 2);
constexpr size_t O_WUKVF = O_WUQ + al256((size_t)768 * 384 * 2);
constexpr size_t O_WUKV = O_WUKVF + al256((size_t)1024 * 256 * 2);
constexpr size_t O_WPA = O_WUKV + al256((size_t)1024 * 256 * 2);
constexpr size_t O_WPB = O_WPA + al256((size_t)1024 * 512 * 2);
constexpr size_t O_WPC = O_WPB + al256((size_t)1024 * 512 * 2);
constexpr size_t O_WO = O_WPC + al256((size_t)1024 * 512 * 2);
constexpr size_t O_MOD = O_WO + al256((size_t)1024 * 1024 * 2);
constexpr size_t O_H = O_MOD + al256((size_t)5 * 2 * 9 * 3072 * 4);
constexpr size_t O_U = O_H + al256((size_t)TG * 1024 * 2);
constexpr size_t O_GAB = O_U + al256((size_t)TG * UC * 2);
constexpr size_t O_Q = O_GAB + al256((size_t)TG * 32 * 4);
constexpr size_t O_KV = O_Q + al256((size_t)TG * 768 * 2);
constexpr size_t O_KR = O_KV + al256((size_t)KVROWS * 1024 * 2);
constexpr size_t O_CKVC = O_KR + al256((size_t)KVROWS * 32 * 2);
constexpr size_t O_GD = O_CKVC + al256((size_t)1024 * 256 * 2);
constexpr size_t O_OF = O_GD + al256((size_t)2 * 128 * 8 * 16384 * 2);
constexpr size_t O_OR = O_OF + al256((size_t)TG * 512 * 2);
constexpr size_t O_BAR = O_OR + al256((size_t)TG * 512 * 2);
constexpr size_t WS_NEED = O_BAR + 16384;
#define WSP(T, name, off) DI T* name(const Params& P) { return (T*)(P.ws + (off)); }
WSP(u16, pWT1, O_WT1) WSP(u16, pWUQ, O_WUQ) WSP(u16, pWUKVF, O_WUKVF) WSP(u16, pWUKV, O_WUKV) WSP(u16, pWPA, O_WPA)
WSP(u16, pWPB, O_WPB) WSP(u16, pWPC, O_WPC) WSP(u16, pWO, O_WO) WSP(float, pMOD, O_MOD) WSP(u16, pH, O_H) WSP(u16, pU, O_U)
WSP(float, pGAB, O_GAB) WSP(u16, pQ, O_Q) WSP(u16, pKV, O_KV) WSP(u16, pKR, O_KR) WSP(u16, pCKVC, O_CKVC) WSP(u16, pGD, O_GD)
WSP(u16, pOF, O_OF) WSP(u16, pOR, O_OR) WSP(float, pMF, O_GD)

struct Grp { int tok0, nseq, seqlen, latent, seq0, nchunk, kvlen; };
DI Grp make_grp(int g) {
  Grp r;
  if (g == 0) { r.tok0 = 0; r.nseq = 32; r.seqlen = 256; r.latent = 0; r.seq0 = 0; r.kvlen = 256; }
  else { r.tok0 = 8192 * g; r.nseq = 4; r.seqlen = 2048; r.latent = 1; r.seq0 = (g - 1) * 4; r.kvlen = 2304; }
  r.nchunk = r.seqlen / 64;
  return r;
}

DI int otid() { int t = __builtin_amdgcn_workitem_id_x(); asm volatile("" : "+v"(t)); return t; }
DI unsigned pk2(float a, float b) { bf2_t v; v[0] = (__bf16)a; v[1] = (__bf16)b; return __builtin_bit_cast(unsigned, v); }
DI u16 f2bf(float a) { return __builtin_bit_cast(u16, (__bf16)a); }
DI float bf2f(u16 x) { return __uint_as_float(((unsigned)x) << 16); }
DI float bflo(unsigned w) { return __uint_as_float(w << 16); }
DI float bfhi(unsigned w) { return __uint_as_float(w & 0xffff0000u); }
DI void unpack8(uint4 w, float* v) {
  v[0] = bflo(w.x); v[1] = bfhi(w.x); v[2] = bflo(w.y); v[3] = bfhi(w.y);
  v[4] = bflo(w.z); v[5] = bfhi(w.z); v[6] = bflo(w.w); v[7] = bfhi(w.w);
}
DI uint4 pack8(const float* v) { return make_uint4(pk2(v[0], v[1]), pk2(v[2], v[3]), pk2(v[4], v[5]), pk2(v[6], v[7])); }
DI float silu_f(float x) { return x / (1.f + __expf(-x)); }
DI float sigmoid_f(float x) { return 1.f / (1.f + __expf(-x)); }
DI int crow(int i, int h) { return (i & 3) + 8 * (i >> 2) + 4 * h; }
DI int swap23(int k) { return (k & ~12) | ((k & 4) << 1) | ((k & 8) >> 1); }
DI float wave_sum(float v) {
  v += __shfl_xor(v, 32); v += __shfl_xor(v, 16); v += __shfl_xor(v, 8);
  v += __shfl_xor(v, 4); v += __shfl_xor(v, 2); v += __shfl_xor(v, 1);
  return v;
}
DI bf16x8 pack_frag(const f32x16& x, int s) {
  uint4 p = make_uint4(pk2(x[8 * s], x[8 * s + 1]), pk2(x[8 * s + 2], x[8 * s + 3]), pk2(x[8 * s + 4], x[8 * s + 5]),
                       pk2(x[8 * s + 6], x[8 * s + 7]));
  return __builtin_bit_cast(bf16x8, p);
}
DI f32x16 zero16() { f32x16 z; for (int i = 0; i < 16; ++i) z[i] = 0.f; return z; }
DI void rope8(float* v, int pi0, int tpos) {
#pragma unroll
  for (int j = 0; j < 4; ++j) {
    int pi = pi0 + j;
    int f = pi & 7;
    float pos = (float)((pi < 8) ? (tpos >> 6) : (tpos & 63));
    float ang = pos * __builtin_amdgcn_exp2f(-(float)f * 1.6609640474436813f);
    float cs = __cosf(ang), sn = __sinf(ang);
    float x0 = v[2 * j], x1 = v[2 * j + 1];
    v[2 * j] = x0 * cs - x1 * sn;
    v[2 * j + 1] = x0 * sn + x1 * cs;
  }
}

DI void mod_item(const Params& P, int it, float* lds) {
  const int kq4 = it & 3, cg = (it >> 2) % 48, l = it / 192;
  const int c0 = cg * 64;
  int tid = otid();
  float* sc = lds;
  for (int i = tid; i < 9 * 256; i += 256) {
    int b = i >> 8, k = kq4 * 256 + (i & 255);
    float cv = (b == 0) ? P.c_ctx[k] : P.c[(b - 1) * 1024 + k];
    sc[i] = silu_f(cv);
  }
  __syncthreads();
  int col = tid & 63, kq = tid >> 6;
  float acc[9];
#pragma unroll
  for (int b = 0; b < 9; ++b) acc[b] = 0.f;
  const float* w = P.w_ada + (size_t)l * 1024 * 3072 + (size_t)(kq4 * 256 + kq * 64) * 3072 + c0 + col;
#pragma unroll 8
  for (int k = 0; k < 64; ++k) {
    float wv = w[(size_t)k * 3072];
#pragma unroll
    for (int b = 0; b < 9; ++b) acc[b] += sc[b * 256 + kq * 64 + k] * wv;
  }
  float* red = lds + 9 * 256;
#pragma unroll
  for (int b = 0; b < 9; ++b) red[(kq * 9 + b) * 64 + col] = acc[b];
  __syncthreads();
  for (int i = tid; i < 9 * 64; i += 256) {
    int b = i >> 6, cc = i & 63;
    float s = red[(0 * 9 + b) * 64 + cc] + red[(1 * 9 + b) * 64 + cc] + red[(2 * 9 + b) * 64 + cc] + red[(3 * 9 + b) * 64 + cc];
    if (kq4 == 0) s += P.b_ada[l * 3072 + c0 + cc];
    pMOD(P)[(size_t)kq4 * 55296 + (l * 9 + b) * 3072 + c0 + cc] = s;
  }
  __syncthreads();
}
DI float4 mod4(const float* p) {
  float4 a = *(const float4*)p, b = *(const float4*)(p + 55296), c = *(const float4*)(p + 2 * 55296), d = *(const float4*)(p + 3 * 55296);
  return make_float4(a.x + b.x + c.x + d.x, a.y + b.y + c.y + d.y, a.z + b.z + c.z + d.z, a.w + b.w + c.w + d.w);
}

DI void convT_tile(const float* __restrict__ src, int K, int N, u16* __restrict__ dst, const float* __restrict__ g, int tk, int tn, float* lds) {
  int tid = otid();
  int k0 = tk * 64, n0 = tn * 64;
  for (int i = tid; i < 4096; i += 256) {
    int kk = i >> 6, nn = i & 63;
    float v = src[(size_t)(k0 + kk) * N + n0 + nn];
    if (g) v *= g[k0 + kk];
    lds[kk * 65 + nn] = v;
  }
  __syncthreads();
  for (int i = tid; i < 512; i += 256) {
    int nn = i >> 3, kc = (i & 7) * 8;
    float v[8];
#pragma unroll
    for (int j = 0; j < 8; ++j) v[j] = lds[(kc + j) * 65 + nn];
    *(uint4*)&dst[(size_t)(n0 + nn) * K + k0 + kc] = pack8(v);
  }
  __syncthreads();
}

DI void convert_phase(const Params& P, int l, float* lds) {
  for (int it = blockIdx.x; it < 2936; it += gridDim.x) {
    int i = it;
    if (i < 2096) { convT_tile(P.w_in + (size_t)l * 1024 * DIN, 1024, DIN, pWT1(P), nullptr, i % 16, i / 16, lds); continue; }
    i -= 2096;
    if (i < 72) { convT_tile(P.w_uq + (size_t)l * 384 * 768, 384, 768, pWUQ(P), P.q_norm_g + l * 384, i % 6, i / 6, lds); continue; }
    i -= 72;
    if (i < 64) { convT_tile(P.w_ukv + (size_t)l * 256 * 1024, 256, 1024, pWUKVF(P), P.kv_norm_g + l * 256, i % 4, i / 4, lds); continue; }
    i -= 64;
    if (i < 64) { convT_tile(P.w_ukv + (size_t)l * 256 * 1024, 256, 1024, pWUKV(P), nullptr, i % 4, i / 4, lds); continue; }
    i -= 64;
    if (i < 128) { convT_tile(P.w_pa + (size_t)l * 512 * 1024, 512, 1024, pWPA(P), nullptr, i % 8, i / 8, lds); continue; }
    i -= 128;
    if (i < 128) { convT_tile(P.w_pb + (size_t)l * 512 * 1024, 512, 1024, pWPB(P), nullptr, i % 8, i / 8, lds); continue; }
    i -= 128;
    if (i < 128) { convT_tile(P.w_pc + (size_t)l * 512 * 1024, 512, 1024, pWPC(P), nullptr, i % 8, i / 8, lds); continue; }
    i -= 128;
    convT_tile(P.w_o + (size_t)l * 1024 * 1024, 1024, 1024, pWO(P), nullptr, i % 16, i / 16, lds);
  }
}

DI const float* x_row(const Params& P, int l, int tok) {
  if (l == 0) return (tok < 8192) ? P.x_prompt + (size_t)tok * 1024 : P.x_sample + (size_t)(tok - 8192) * 1024;
  return P.out + (size_t)tok * 1024;
}
DI void norm_phase(const Params& P, const Grp& G, int l, bool first = false) {
  int wave = (blockIdx.x * 256 + otid()) >> 6, lane = otid() & 63, nw = gridDim.x * 4;
  const float* ng = P.norm_g + l * 1024;
  for (int r = wave; r < TG; r += nw) {
    int tok = G.tok0 + r;
    const float* xr = x_row(P, l, tok);
    int cond = G.latent ? 1 + G.seq0 + (r >> 11) : 0;
    const float* mod = pMOD(P) + (l * 9 + cond) * 3072;
    float4 v[4];
    float ss = 0.f;
#pragma unroll
    for (int i = 0; i < 4; ++i) {
      v[i] = *(const float4*)(xr + i * 256 + lane * 4);
      ss += v[i].x * v[i].x + v[i].y * v[i].y + v[i].z * v[i].z + v[i].w * v[i].w;
    }
    ss = wave_sum(ss);
    float rstd = rsqrtf(ss * (1.f / 1024.f) + 1e-6f);
#pragma unroll
    for (int i = 0; i < 4; ++i) {
      int col = i * 256 + lane * 4;
      float4 gg = *(const float4*)(ng + col);
      float4 sh = first ? mod4(mod + col) : *(const float4*)(mod + 4 * 55296 + col);
      float4 scl = first ? mod4(mod + 1024 + col) : *(const float4*)(mod + 4 * 55296 + 1024 + col);
      float h0 = v[i].x * rstd * gg.x * (1.f + scl.x) + sh.x;
      float h1 = v[i].y * rstd * gg.y * (1.f + scl.y) + sh.y;
      float h2 = v[i].z * rstd * gg.z * (1.f + scl.z) + sh.z;
      float h3 = v[i].w * rstd * gg.w * (1.f + scl.w) + sh.w;
      *(uint2*)&pH(P)[(size_t)r * 1024 + col] = make_uint2(pk2(h0, h1), pk2(h2, h3));
    }
  }
  if (G.latent) {
    int gt = blockIdx.x * 256 + otid(), nth = gridDim.x * 256;
    for (int i = gt; i < 1024 * 256; i += nth) {
      int row = i >> 8, cc = i & 255;
      int sl = row >> 8, p = row & 255;
      pCKVC(P)[i] = f2bf(P.cache_ckv[(((size_t)(G.seq0 + sl) * 2 + l) * 256 + p) * 256 + cc]);
    }
    for (int i = gt; i < 1024 * 32; i += nth) {
      int row = i >> 5, cc = i & 31;
      int sl = row >> 8, p = row & 255;
      pKR(P)[((size_t)sl * 2304 + p) * 32 + cc] = f2bf(P.cache_kpe[(((size_t)(G.seq0 + sl) * 2 + l) * 256 + p) * 32 + cc]);
    }
  }
}

DI void g_load(u32x4 (&ra)[4], u32x4 (&rb)[4], const u16* ga, const u16* gb, size_t sa32, size_t sb32, int kt) {
#pragma unroll
  for (int i = 0; i < 4; ++i) {
    ra[i] = *(const u32x4*)(ga + i * sa32 + kt * 64);
    rb[i] = *(const u32x4*)(gb + i * sb32 + kt * 64);
  }
}
DI void l_store(const u32x4 (&ra)[4], const u32x4 (&rb)[4], u16* dA, u16* dB, int lrow, int lcol) {
#pragma unroll
  for (int i = 0; i < 4; ++i) {
    *(u32x4*)&dA[(lrow + 32 * i) * 72 + lcol] = ra[i];
    *(u32x4*)&dB[(lrow + 32 * i) * 72 + lcol] = rb[i];
  }
}
DI void t_compute(const u16* cA, const u16* cB, f32x16 (&acc)[2][2]) {
#pragma unroll
  for (int s = 0; s < 4; ++s) {
    bf16x8 a0 = *(const bf16x8*)(cA + s * 16);
    bf16x8 a1 = *(const bf16x8*)(cA + 32 * 72 + s * 16);
    bf16x8 b0 = *(const bf16x8*)(cB + s * 16);
    bf16x8 b1 = *(const bf16x8*)(cB + 32 * 72 + s * 16);
    acc[0][0] = MFMA32(a0, b0, acc[0][0]);
    acc[0][1] = MFMA32(a0, b1, acc[0][1]);
    acc[1][0] = MFMA32(a1, b0, acc[1][0]);
    acc[1][1] = MFMA32(a1, b1, acc[1][1]);
  }
}
DI void gemm_mainloop(const u16* __restrict__ A, int lda, const u16* __restrict__ B, int ldb, int K, u16* lds, f32x16 (&acc)[2][2]) {
  const int tid = otid(), lane = tid & 63, w = tid >> 6, wr = w >> 1, wc = w & 1, r = lane & 31, h = lane >> 5;
  u16* sA = lds;
  u16* sB = lds + 2 * 128 * 72;
  const int lrow = tid >> 3, lcol = (tid & 7) * 8;
  const u16* ga = A + (size_t)lrow * lda + lcol;
  const u16* gb = B + (size_t)lrow * ldb + lcol;
  const size_t sa32 = (size_t)32 * lda, sb32 = (size_t)32 * ldb;
  u32x4 ra0[4], rb0[4], ra1[4], rb1[4];
  const int nk = K >> 6;
  const u16* cA = sA + (wr * 64 + r) * 72 + h * 8;
  const u16* cB = sB + (wc * 64 + r) * 72 + h * 8;
  g_load(ra0, rb0, ga, gb, sa32, sb32, 0);
  g_load(ra1, rb1, ga, gb, sa32, sb32, 1);
  l_store(ra0, rb0, sA, sB, lrow, lcol);
  __syncthreads();
  for (int kt = 0; kt < nk; kt += 2) {
    if (kt + 2 < nk) g_load(ra0, rb0, ga, gb, sa32, sb32, kt + 2);
    t_compute(cA, cB, acc);
    l_store(ra1, rb1, sA + 128 * 72, sB + 128 * 72, lrow, lcol);
    __syncthreads();
    if (kt + 3 < nk) g_load(ra1, rb1, ga, gb, sa32, sb32, kt + 3);
    t_compute(cA + 128 * 72, cB + 128 * 72, acc);
    if (kt + 2 < nk) l_store(ra0, rb0, sA, sB, lrow, lcol);
    __syncthreads();
  }
}

DI void gemm_mainloop1(const u16* __restrict__ A, int lda, const u16* __restrict__ B, int ldb, int K, u16* lds, f32x16 (&acc)[2][2]) {
  const int tid = otid(), lane = tid & 63, w = tid >> 6, wr = w >> 1, wc = w & 1, r = lane & 31, h = lane >> 5;
  u16* sA = lds;
  u16* sB = lds + 2 * 128 * 72;
  const int lrow = tid >> 3, lcol = (tid & 7) * 8;
  const u16* ga = A + (size_t)lrow * lda + lcol;
  const u16* gb = B + (size_t)lrow * ldb + lcol;
  const size_t sa32 = (size_t)32 * lda, sb32 = (size_t)32 * ldb;
  u32x4 ra[4], rb[4];
  const int nk = K >> 6;
  const u16* cA = sA + (wr * 64 + r) * 72 + h * 8;
  const u16* cB = sB + (wc * 64 + r) * 72 + h * 8;
  g_load(ra, rb, ga, gb, sa32, sb32, 0);
  l_store(ra, rb, sA, sB, lrow, lcol);
  __syncthreads();
  for (int kt = 0; kt < nk; ++kt) {
    const int cur = kt & 1;
    if (kt + 1 < nk) g_load(ra, rb, ga, gb, sa32, sb32, kt + 1);
    t_compute(cA + cur * 128 * 72, cB + cur * 128 * 72, acc);
    if (kt + 1 < nk) l_store(ra, rb, sA + (cur ^ 1) * 128 * 72, sB + (cur ^ 1) * 128 * 72, lrow, lcol);
    __syncthreads();
  }
}

template <int UNR = 2, class F>
DI void gemm_epilogue(f32x16 (&acc)[2][2], float* cs, F f) {
  const int tid = otid(), lane = tid & 63, w = tid >> 6, wr = w >> 1, wc = w & 1, r = lane & 31, h = lane >> 5;
#pragma unroll
  for (int mt = 0; mt < 2; ++mt)
#pragma unroll
    for (int nt = 0; nt < 2; ++nt)
#pragma unroll
      for (int i = 0; i < 16; ++i) cs[(wr * 64 + mt * 32 + crow(i, h)) * 132 + wc * 64 + nt * 32 + r] = acc[mt][nt][i];
  __syncthreads();
#pragma unroll UNR
  for (int it = 0; it < 8; ++it) {
    int c = tid + 256 * it;
    int row = c >> 4, col = (c & 15) * 8;
    float v[8];
    float4 a = *(const float4*)&cs[row * 132 + col];
    float4 b = *(const float4*)&cs[row * 132 + col + 4];
    v[0] = a.x; v[1] = a.y; v[2] = a.z; v[3] = a.w; v[4] = b.x; v[5] = b.y; v[6] = b.z; v[7] = b.w;
    f(row, col, v);
  }
  __syncthreads();
}

DI void stagger() { if (blockIdx.x >= (gridDim.x >> 1)) __builtin_amdgcn_s_sleep(24); }
DI void gemm1_tile(const Params& P, const Grp& G, int l, int mtile, int ntile, char* ldsraw) {
  u16* lds = (u16*)ldsraw;
  {
    const int m0 = mtile * 128, n0 = ntile * 128;
    f32x16 acc[2][2];
    acc[0][0] = zero16(); acc[0][1] = zero16(); acc[1][0] = zero16(); acc[1][1] = zero16();
    gemm_mainloop(pH(P) + (size_t)m0 * 1024, 1024, pWT1(P) + (size_t)n0 * 1024, 1024, 1024, lds, acc);
    gemm_epilogue(acc, (float*)ldsraw, [&](int row, int col, float* v) {
      int n = n0 + col;
      if (n >= UC) return;
      int lt = m0 + row;
      *(uint4*)&pU(P)[(size_t)lt * UC + n] = pack8(v);
      if (n >= C_KPE && n < C_KPE + 32) {
        int cc = n - C_KPE;
        int sl = lt / G.seqlen, tpos = lt % G.seqlen;
        if (!G.latent) {
          float* dst = P.out + OUT_KPE + (((size_t)sl * 2 + l) * 256 + tpos) * 32 + cc;
          *(float4*)dst = make_float4(v[0], v[1], v[2], v[3]);
          *(float4*)(dst + 4) = make_float4(v[4], v[5], v[6], v[7]);
          *(uint4*)&pKR(P)[(size_t)lt * 32 + cc] = pack8(v);
        } else {
          rope8(v, cc >> 1, tpos);
          *(uint4*)&pKR(P)[((size_t)sl * 2304 + 256 + tpos) * 32 + cc] = pack8(v);
        }
      } else if (n >= C_AB) {
        float* dst = pGAB(P) + (size_t)lt * 32 + (n - C_AB);
        *(float4*)dst = make_float4(v[0], v[1], v[2], v[3]);
        *(float4*)(dst + 4) = make_float4(v[4], v[5], v[6], v[7]);
      }
    });
  }
}
DI void gemm1_phase(const Params& P, const Grp& G, int l, char* ldsraw) {
  for (int it = blockIdx.x; it < 64 * 40; it += gridDim.x) {
    int xcd = it & 7, j = it >> 3;
    int sj = j / 40, q = j % 40;
    int S = xcd + 8 * sj;
    int mtile = (S & 7) * 8 + (q & 7), nidx = (S >> 3) * 5 + (q >> 3);
    gemm1_tile(P, G, l, mtile, nidx < 6 ? nidx : nidx + 2, ldsraw);
  }
}

DI void rowstat(const u16* __restrict__ A, int lda, int K, float* rs) {
  int tid = otid();
  int row = tid >> 1, half = tid & 1;
  const u16* p = A + (size_t)row * lda + half * (K >> 1);
  float ss = 0.f;
  for (int c = 0; c < (K >> 4); ++c) {
    float v[8];
    unpack8(*(const uint4*)(p + c * 8), v);
#pragma unroll
    for (int j = 0; j < 8; ++j) ss += v[j] * v[j];
  }
  ss += __shfl_xor(ss, 1);
  if (half == 0) rs[row] = rsqrtf(ss / (float)K + 1e-6f);
  __syncthreads();
}

DI void qproj_tile(const Params& P, const Grp& G, int it, char* ldsraw) {
  u16* lds = (u16*)ldsraw;
  float* rs = (float*)(ldsraw + LDS_MAIN);
  int mtile = it / 6, ntile = it % 6;
  int m0 = mtile * 128, n0 = ntile * 128;
  const u16* A = pU(P) + (size_t)m0 * UC + C_CQ;
  rowstat(A, UC, 384, rs);
  f32x16 acc[2][2];
  acc[0][0] = zero16(); acc[0][1] = zero16(); acc[1][0] = zero16(); acc[1][1] = zero16();
  gemm_mainloop(A, UC, pWUQ(P) + (size_t)n0 * 384, 384, 384, lds, acc);
  gemm_epilogue(acc, (float*)ldsraw, [&](int row, int col, float* v) {
    int n = n0 + col, lt = m0 + row;
    float s = rs[row];
#pragma unroll
    for (int j = 0; j < 8; ++j) v[j] *= s;
    int d = n % 96;
    if (G.latent && d >= 64) rope8(v, (d - 64) >> 1, lt & 2047);
    *(uint4*)&pQ(P)[(size_t)lt * 768 + n] = pack8(v);
  });
}

DI void kvexp_tile(const Params& P, const Grp& G, int l, int it, char* ldsraw) {
  u16* lds = (u16*)ldsraw;
  float* rs = (float*)(ldsraw + LDS_MAIN);
  int mtile = it >> 3, ntile = it & 7;
  int n0 = ntile * 128;
  const bool cache = mtile >= 64;
  int m0 = (cache ? (mtile - 64) : mtile) * 128;
  const u16* A;
  int lda;
  const u16* W;
  if (!cache) {
    A = pU(P) + (size_t)m0 * UC + C_CKV; lda = UC; W = pWUKVF(P);
    rowstat(A, UC, 256, rs);
  } else {
    A = pCKVC(P) + (size_t)m0 * 256; lda = 256; W = pWUKV(P);
    if (otid() < 128) rs[otid()] = 1.f;
    __syncthreads();
  }
  f32x16 acc[2][2];
  acc[0][0] = zero16(); acc[0][1] = zero16(); acc[1][0] = zero16(); acc[1][1] = zero16();
  gemm_mainloop(A, lda, W + (size_t)n0 * 256, 256, 256, lds, acc);
  gemm_epilogue(acc, (float*)ldsraw, [&](int row, int col, float* v) {
    int n = n0 + col, lr = m0 + row;
    float s = rs[row];
#pragma unroll
    for (int j = 0; j < 8; ++j) v[j] *= s;
    size_t kvrow;
    if (!G.latent) kvrow = lr;
    else if (!cache) kvrow = (size_t)(lr >> 11) * 2304 + 256 + (lr & 2047);
    else kvrow = (size_t)(lr >> 8) * 2304 + (lr & 255);
    *(uint4*)&pKV(P)[kvrow * 1024 + n] = pack8(v);
  });
  if (!G.latent && ntile == 0) {
    const float* kg = P.kv_norm_g + l * 256;
    for (int c = otid(); c < 128 * 32; c += 256) {
      int row = c >> 5, c8 = (c & 31) * 8;
      int lt = m0 + row;
      float v[8];
      unpack8(*(const uint4*)&pU(P)[(size_t)lt * UC + C_CKV + c8], v);
      float s = rs[row];
      float* dst = P.out + OUT_CKV + (((size_t)(lt >> 8) * 2 + l) * 256 + (lt & 255)) * 256 + c8;
      *(float4*)dst = make_float4(v[0] * s * kg[c8], v[1] * s * kg[c8 + 1], v[2] * s * kg[c8 + 2], v[3] * s * kg[c8 + 3]);
      *(float4*)(dst + 4) = make_float4(v[4] * s * kg[c8 + 4], v[5] * s * kg[c8 + 5], v[6] * s * kg[c8 + 6], v[7] * s * kg[c8 + 7]);
    }
    __syncthreads();
  }
}

DI f32x16 mm64_tile(const u16* A, const u16* Bt, int tm, int tn, int r, int h) {
  f32x16 acc = zero16();
  const u16* pa = A + (32 * tm + r) * 72 + 8 * h;
  const u16* pb = Bt + (32 * tn + r) * 72 + 8 * h;
#pragma unroll
  for (int s = 0; s < 4; ++s) acc = MFMA32(*(const bf16x8*)(pa + 16 * s), *(const bf16x8*)(pb + 16 * s), acc);
  return acc;
}

DI void gdn_prep_item(const Params& P, const Grp& G, int l, int it, char* ldsraw) {
  const int tid0 = otid();
  int t2 = it;
  const int N = G.nchunk;
  const int ctok = t2 % N; t2 /= N;
  const int head = t2 & 7, sl = t2 >> 3;
  u16* lds = (u16*)ldsraw;
  u16* Kn = lds;
  u16* Qn = lds + 4608;
  u16* VTb = lds + 9216;
  u16* KTb = lds + 13824;
  u16* KdT = lds + 18432;
  u16* AT = lds + 23040;
  float* Lf = (float*)(lds + 27648);
  float* sm = (float*)(ldsraw + LDS_MAIN);
  float* s_gc = sm; float* s_beta = sm + 64; float* s_eg = sm + 128; float* s_ekd = sm + 192;

  unsigned yp[3][8];
  {
    const int i = tid0 >> 2, part = tid0 & 3;
    const int tpos = ctok * 64 + i;
    const size_t lt = (size_t)sl * G.seqlen + tpos;
#pragma unroll
    for (int m = 0; m < 3; ++m) {
      const int cb = C_Q + m * 512 + head * 64 + part * 16;
      const float* cw = P.conv_qkv_w + (size_t)l * 3 * 1536 + m * 512 + head * 64 + part * 16;
      float y[16];
#pragma unroll
      for (int hf = 0; hf < 2; ++hf) {
        float xc[8], xm[8], xp[8];
        unpack8(*(const uint4*)&pU(P)[lt * UC + cb + hf * 8], xc);
        if (tpos > 0) unpack8(*(const uint4*)&pU(P)[(lt - 1) * UC + cb + hf * 8], xm);
        else { for (int j = 0; j < 8; ++j) xm[j] = 0.f; }
        if (tpos < G.seqlen - 1) unpack8(*(const uint4*)&pU(P)[(lt + 1) * UC + cb + hf * 8], xp);
        else { for (int j = 0; j < 8; ++j) xp[j] = 0.f; }
        float w0[8], w1[8], w2[8];
        *(float4*)&w0[0] = *(const float4*)(cw + hf * 8); *(float4*)&w0[4] = *(const float4*)(cw + hf * 8 + 4);
        *(float4*)&w1[0] = *(const float4*)(cw + 1536 + hf * 8); *(float4*)&w1[4] = *(const float4*)(cw + 1536 + hf * 8 + 4);
        *(float4*)&w2[0] = *(const float4*)(cw + 3072 + hf * 8); *(float4*)&w2[4] = *(const float4*)(cw + 3072 + hf * 8 + 4);
#pragma unroll
        for (int j = 0; j < 8; ++j) y[hf * 8 + j] = silu_f(xm[j] * w0[j] + xc[j] * w1[j] + xp[j] * w2[j]);
      }
      if (m < 2) {
        float sq = 0.f;
#pragma unroll
        for (int j = 0; j < 16; ++j) sq += y[j] * y[j];
        sq += __shfl_xor(sq, 1); sq += __shfl_xor(sq, 2);
        float iq = rsqrtf(sq + 1e-6f) * ((m == 0) ? 0.125f : 1.f);
#pragma unroll
        for (int j = 0; j < 16; ++j) y[j] *= iq;
      }
#pragma unroll
      for (int j = 0; j < 8; ++j) yp[m][j] = pk2(y[2 * j], y[2 * j + 1]);
    }
  }
  int ndir = 2;
  asm volatile("" : "+s"(ndir));
  for (int dir = 0; dir < ndir; ++dir) {
  const int tid = otid(), lane = tid & 63, w = tid >> 6, r = lane & 31, h = lane >> 5;
  const int i = tid >> 2, part = tid & 3;
  if (tid < 64) {
    const int ti = tid;
    const int tp = dir ? (ctok * 64 + 63 - ti) : (ctok * 64 + ti);
    const size_t ltg = (size_t)sl * G.seqlen + tp;
    float a = pGAB(P)[ltg * 32 + dir * 8 + head];
    float b = pGAB(P)[ltg * 32 + 16 + dir * 8 + head];
    float xs = a + P.dt_bias[l * 16 + dir * 8 + head];
    float sp = (xs > 20.f) ? xs : log1pf(__expf(xs));
    float g = -__expf(P.a_log[l * 16 + dir * 8 + head]) * sp;
#pragma unroll
    for (int off = 1; off < 64; off <<= 1) {
      float t = __shfl_up(g, off);
      if (ti >= off) g += t;
    }
    float gl = __shfl(g, 63);
    s_gc[ti] = g; s_beta[ti] = sigmoid_f(b); s_eg[ti] = __expf(g); s_ekd[ti] = __expf(gl - g);
  }
  __syncthreads();
  {
    const int ri = dir ? (63 - i) : i;
    const float be = s_beta[ri], eg = s_eg[ri], ekd = s_ekd[ri];
    *(uint4*)&Qn[ri * 72 + part * 16] = make_uint4(yp[0][0], yp[0][1], yp[0][2], yp[0][3]);
    *(uint4*)&Qn[ri * 72 + part * 16 + 8] = make_uint4(yp[0][4], yp[0][5], yp[0][6], yp[0][7]);
    *(uint4*)&Kn[ri * 72 + part * 16] = make_uint4(yp[1][0], yp[1][1], yp[1][2], yp[1][3]);
    *(uint4*)&Kn[ri * 72 + part * 16 + 8] = make_uint4(yp[1][4], yp[1][5], yp[1][6], yp[1][7]);
#pragma unroll
    for (int j = 0; j < 8; ++j) {
      const int cc = part * 16 + 2 * j;
      const float k0 = bflo(yp[1][j]), k1 = bfhi(yp[1][j]), v0 = bflo(yp[2][j]), v1 = bfhi(yp[2][j]);
      KTb[cc * 72 + ri] = f2bf(k0 * be * eg);  KTb[(cc + 1) * 72 + ri] = f2bf(k1 * be * eg);
      KdT[cc * 72 + ri] = f2bf(k0 * ekd);      KdT[(cc + 1) * 72 + ri] = f2bf(k1 * ekd);
      VTb[cc * 72 + ri] = f2bf(v0 * be);       VTb[(cc + 1) * 72 + ri] = f2bf(v1 * be);
    }
  }
  __syncthreads();
  const int tm = w >> 1, tn = w & 1;
  {
    f32x16 aK = mm64_tile(Kn, Kn, tm, tn, r, h);
    f32x16 aQ = mm64_tile(Qn, Kn, tm, tn, r, h);
    const int jj = 32 * tn + r;
    const float gcj = s_gc[jj];
#pragma unroll
    for (int ii = 0; ii < 16; ++ii) {
      const int ri = 32 * tm + crow(ii, h);
      float dec = (ri >= jj) ? __expf(s_gc[ri] - gcj) : 0.f;
      Lf[ri * 72 + jj] = (ri > jj) ? s_beta[ri] * aK[ii] * dec : 0.f;
      AT[ri * 72 + jj] = f2bf(aQ[ii] * dec);
    }
  }
  __syncthreads();
  float* Pf = (float*)Kn;
  if (w == 0) {
    const int b = lane >> 4, c = lane & 15;
    float t[16];
#pragma unroll
    for (int a = 0; a < 16; ++a) {
      float s = (a == c) ? 1.f : 0.f;
#pragma unroll
      for (int j = 0; j < a; ++j) s -= Lf[(16 * b + a) * 72 + 16 * b + j] * t[j];
      t[a] = s;
    }
#pragma unroll
    for (int a = 0; a < 16; ++a) Lf[(16 * b + a) * 72 + 16 * b + c] = t[a];
  }
  __syncthreads();
  for (int idx = tid; idx < 512; idx += 256) {
    const int p = idx >> 8, a = (idx >> 4) & 15, j = idx & 15;
    float s = 0.f;
#pragma unroll
    for (int k = 0; k < 16; ++k) s += Lf[(32 * p + 16 + a) * 72 + 32 * p + k] * Lf[(32 * p + k) * 72 + 32 * p + j];
    Pf[p * 256 + a * 16 + j] = s;
  }
  __syncthreads();
  for (int idx = tid; idx < 512; idx += 256) {
    const int p = idx >> 8, a = (idx >> 4) & 15, j = idx & 15;
    float s = 0.f;
#pragma unroll
    for (int k = 0; k < 16; ++k) s += Lf[(32 * p + 16 + a) * 72 + 32 * p + 16 + k] * Pf[p * 256 + k * 16 + j];
    Lf[(32 * p + 16 + a) * 72 + 32 * p + j] = -s;
  }
  __syncthreads();
  if (w == 0) {
    f32x16 acc = zero16();
#pragma unroll
    for (int s2 = 0; s2 < 16; ++s2)
      acc = __builtin_amdgcn_mfma_f32_32x32x2f32(Lf[(32 + r) * 72 + 2 * s2 + h], Lf[(2 * s2 + h) * 72 + r], acc, 0, 0, 0);
#pragma unroll
    for (int ii = 0; ii < 16; ++ii) Pf[crow(ii, h) * 32 + r] = acc[ii];
  }
  __syncthreads();
  if (w == 0) {
    f32x16 acc = zero16();
#pragma unroll
    for (int s2 = 0; s2 < 16; ++s2)
      acc = __builtin_amdgcn_mfma_f32_32x32x2f32(Lf[(32 + r) * 72 + 32 + 2 * s2 + h], Pf[(2 * s2 + h) * 32 + r], acc, 0, 0, 0);
#pragma unroll
    for (int ii = 0; ii < 16; ++ii) Lf[(32 + crow(ii, h)) * 72 + r] = -acc[ii];
  }
  __syncthreads();
  u16* Tb = Kn;
  for (int idx = tid; idx < 4096; idx += 256) {
    const int a = idx >> 6, j = idx & 63;
    Tb[a * 72 + j] = f2bf(Lf[a * 72 + j]);
  }
  __syncthreads();
  u16* UT = (u16*)Lf;
  u16* WT = UT + 4608;
  {
    f32x16 aU = mm64_tile(Tb, VTb, tm, tn, r, h);
    f32x16 aW = mm64_tile(Tb, KTb, tm, tn, r, h);
    __syncthreads();
#pragma unroll
    for (int g4 = 0; g4 < 4; ++g4) {
      const int ci = 32 * tm + 8 * g4 + 4 * h;
      *(uint2*)&UT[(32 * tn + r) * 72 + ci] = make_uint2(pk2(aU[4 * g4], aU[4 * g4 + 1]), pk2(aU[4 * g4 + 2], aU[4 * g4 + 3]));
      *(uint2*)&WT[(32 * tn + r) * 72 + ci] = make_uint2(pk2(aW[4 * g4], aW[4 * g4 + 1]), pk2(aW[4 * g4 + 2], aW[4 * g4 + 3]));
    }
  }
  __syncthreads();
  {
    const int cdir = dir ? (N - 1 - ctok) : ctok;
    u16* gd = pGD(P) + ((((size_t)dir * G.nseq + sl) * 8 + head) * N + cdir) * 16384;
    f32x16 a1 = mm64_tile(AT, WT, tm, tn, r, h);
    f32x16 a3 = mm64_tile(KdT, WT, tm, tn, r, h);
    const int cc = 32 * tn + r;
    const int pc = swap23(cc);
    const float egl = s_eg[63];
#pragma unroll
    for (int ii = 0; ii < 16; ++ii) {
      const int ri = 32 * tm + crow(ii, h);
      float qe = bf2f(Qn[ri * 72 + cc]) * s_eg[ri] - a1[ii];
      float mc = ((ri == cc) ? egl : 0.f) - a3[ii];
      gd[ri * 64 + pc] = f2bf(qe);
      gd[4096 + ri * 64 + pc] = f2bf(mc);
    }
    f32x16 a2 = mm64_tile(AT, UT, tm, tn, r, h);
    f32x16 a4 = mm64_tile(KdT, UT, tm, tn, r, h);
    u16* o3 = gd + 3 * 4096 + ((tm * 2 + tn) * 64 + lane) * 16;
    u16* o2 = gd + 2 * 4096 + ((tm * 2 + tn) * 64 + lane) * 16;
    *(uint4*)o3 = make_uint4(pk2(a2[0], a2[1]), pk2(a2[2], a2[3]), pk2(a2[4], a2[5]), pk2(a2[6], a2[7]));
    *(uint4*)(o3 + 8) = make_uint4(pk2(a2[8], a2[9]), pk2(a2[10], a2[11]), pk2(a2[12], a2[13]), pk2(a2[14], a2[15]));
    *(uint4*)o2 = make_uint4(pk2(a4[0], a4[1]), pk2(a4[2], a4[3]), pk2(a4[4], a4[5]), pk2(a4[6], a4[7]));
    *(uint4*)(o2 + 8) = make_uint4(pk2(a4[8], a4[9]), pk2(a4[10], a4[11]), pk2(a4[12], a4[13]), pk2(a4[14], a4[15]));
  }
  __syncthreads();
  }
}

DI f32x16 unpack16(const u16* p) {
  uint4 a = *(const uint4*)p, b = *(const uint4*)(p + 8);
  f32x16 v;
  v[0] = bflo(a.x); v[1] = bfhi(a.x); v[2] = bflo(a.y); v[3] = bfhi(a.y); v[4] = bflo(a.z); v[5] = bfhi(a.z); v[6] = bflo(a.w); v[7] = bfhi(a.w);
  v[8] = bflo(b.x); v[9] = bfhi(b.x); v[10] = bflo(b.y); v[11] = bfhi(b.y); v[12] = bflo(b.z); v[13] = bfhi(b.z); v[14] = bflo(b.w); v[15] = bfhi(b.w);
  return v;
}

struct ScanOps { bf16x8 qa[2][4], ma[2][4]; u32x4 bc[2][2], ou[2][2]; };
DI void scan_load(ScanOps& o, const u16* mb, int r, int h, int nt, int lane) {
#pragma unroll
  for (int mt = 0; mt < 2; ++mt) {
#pragma unroll
    for (int ks = 0; ks < 4; ++ks) {
      o.qa[mt][ks] = *(const bf16x8*)(mb + (32 * mt + r) * 64 + 16 * ks + 8 * h);
      o.ma[mt][ks] = *(const bf16x8*)(mb + 4096 + (32 * mt + r) * 64 + 16 * ks + 8 * h);
    }
    const u16* pb = mb + 2 * 4096 + ((mt * 2 + nt) * 64 + lane) * 16;
    const u16* po = mb + 3 * 4096 + ((mt * 2 + nt) * 64 + lane) * 16;
    o.bc[mt][0] = *(const u32x4*)pb; o.bc[mt][1] = *(const u32x4*)(pb + 8);
    o.ou[mt][0] = *(const u32x4*)po; o.ou[mt][1] = *(const u32x4*)(po + 8);
  }
}
DI f32x16 unpack16v(u32x4 a, u32x4 b) {
  f32x16 v;
  v[0] = bflo(a[0]); v[1] = bfhi(a[0]); v[2] = bflo(a[1]); v[3] = bfhi(a[1]); v[4] = bflo(a[2]); v[5] = bfhi(a[2]); v[6] = bflo(a[3]); v[7] = bfhi(a[3]);
  v[8] = bflo(b[0]); v[9] = bfhi(b[0]); v[10] = bflo(b[1]); v[11] = bfhi(b[1]); v[12] = bflo(b[2]); v[13] = bfhi(b[2]); v[14] = bflo(b[3]); v[15] = bfhi(b[3]);
  return v;
}
DI void scan_step(const ScanOps& o, f32x16 (&S)[2], u16* obuf, size_t rowbase, int ctok, int dir, int colbase, int h) {
  f32x16 ov[2], Sn[2];
#pragma unroll
  for (int mt = 0; mt < 2; ++mt) {
    Sn[mt] = unpack16v(o.bc[mt][0], o.bc[mt][1]);
    ov[mt] = unpack16v(o.ou[mt][0], o.ou[mt][1]);
  }
  bf16x8 Sb[4];
  Sb[0] = pack_frag(S[0], 0); Sb[1] = pack_frag(S[0], 1); Sb[2] = pack_frag(S[1], 0); Sb[3] = pack_frag(S[1], 1);
#pragma unroll
  for (int mt = 0; mt < 2; ++mt)
#pragma unroll
    for (int ks = 0; ks < 4; ++ks) {
      ov[mt] = MFMA32(o.qa[mt][ks], Sb[ks], ov[mt]);
      Sn[mt] = MFMA32(o.ma[mt][ks], Sb[ks], Sn[mt]);
    }
#pragma unroll
  for (int mt = 0; mt < 2; ++mt)
#pragma unroll
    for (int ii = 0; ii < 16; ++ii) {
      int ri = 32 * mt + crow(ii, h);
      int tpos = dir ? (ctok * 64 + 63 - ri) : (ctok * 64 + ri);
      obuf[(rowbase + tpos) * 512 + colbase] = f2bf(ov[mt][ii]);
    }
  S[0] = Sn[0]; S[1] = Sn[1];
}

DI void gdn_scan_item(const Params& P, const Grp& G, int l, int it) {
  const int tid = otid(), lane = tid & 63, w = tid >> 6, r = lane & 31, h = lane >> 5;
  const int head = it & 7, sl = it >> 3;
  const int dir = w >> 1, nt = w & 1;
  const int N = G.nchunk;
  f32x16 S[2];
  if (G.latent) {
    const float* st = P.state_gdn + ((((size_t)(G.seq0 + sl) * 2 + l) * 2 + dir) * 8 + head) * 4096;
#pragma unroll
    for (int mt = 0; mt < 2; ++mt)
#pragma unroll
      for (int ii = 0; ii < 16; ++ii) S[mt][ii] = st[(32 * mt + crow(ii, h)) * 64 + 32 * nt + r];
  } else { S[0] = zero16(); S[1] = zero16(); }
  const u16* base = pGD(P) + ((((size_t)dir * G.nseq + sl) * 8 + head) * N) * 16384;
  u16* obuf = dir ? pOR(P) : pOF(P);
  const size_t rowbase = (size_t)sl * G.seqlen;
  const int colbase = head * 64 + 32 * nt + r;
  ScanOps oa;
  for (int c = 0; c < N; ++c) {
    scan_load(oa, base + (size_t)c * 16384, r, h, nt, lane);
    scan_step(oa, S, obuf, rowbase, dir ? (N - 1 - c) : c, dir, colbase, h);
  }
  if (!G.latent) {
    float* st = P.out + OUT_ST + ((((size_t)sl * 2 + l) * 2 + dir) * 8 + head) * 4096;
#pragma unroll
    for (int mt = 0; mt < 2; ++mt)
#pragma unroll
      for (int ii = 0; ii < 16; ++ii) st[(32 * mt + crow(ii, h)) * 64 + 32 * nt + r] = S[mt][ii];
  }
  asm volatile("s_waitcnt vmcnt(0)" ::: "memory");
  __syncthreads();
  const float* gn = P.gdn_norm_g + l * 64;
#pragma unroll 4
  for (int idx = tid; idx < G.seqlen * 8; idx += 256) {
    int tpos = idx >> 3, part = idx & 7;
    size_t lt = (size_t)sl * G.seqlen + tpos;
    float a[8], b[8], z[8];
    unpack8(*(const uint4*)&pOF(P)[lt * 512 + head * 64 + part * 8], a);
    unpack8(*(const uint4*)&pOR(P)[lt * 512 + head * 64 + part * 8], b);
    u16* zp = &pU(P)[lt * UC + C_Z + head * 64 + part * 8];
    unpack8(*(const uint4*)zp, z);
    float ss = 0.f;
#pragma unroll
    for (int j = 0; j < 8; ++j) { a[j] += b[j]; ss += a[j] * a[j]; }
    ss += __shfl_xor(ss, 1); ss += __shfl_xor(ss, 2); ss += __shfl_xor(ss, 4);
    float rstd = rsqrtf(ss * (1.f / 64.f) + 1e-6f);
#pragma unroll
    for (int j = 0; j < 8; ++j) a[j] = a[j] * rstd * gn[part * 8 + j] * silu_f(z[j]);
    *(uint4*)zp = pack8(a);
  }
  __syncthreads();
}

struct KvRegs { u32x4 k[2], kr, v[2]; };
DI void attn_gload(KvRegs& g, const u16* kvp, const u16* krp, size_t row0, int tid, int head) {
#pragma unroll
  for (int i2 = 0; i2 < 2; ++i2) {
    int c = tid + 256 * i2;
    int key = c >> 3, d8 = (c & 7) * 8;
    const u16* src = &kvp[(row0 + key) * 1024 + head * 128 + d8];
    g.k[i2] = *(const u32x4*)src;
    g.v[i2] = *(const u32x4*)(src + 64);
  }
  g.kr = *(const u32x4*)&krp[(row0 + (tid >> 2)) * 32 + (tid & 3) * 8];
}
DI void attn_lstore(const KvRegs& g, u16* Kl, u16* Vt, int tid) {
#pragma unroll
  for (int i2 = 0; i2 < 2; ++i2) {
    int c = tid + 256 * i2;
    int key = c >> 3, d8 = (c & 7) * 8;
    *(u32x4*)&Kl[key * 104 + d8] = g.k[i2];
    u32x4 vv = g.v[i2];
    u16* vd = &Vt[d8 * 72 + key];
    vd[0] = (u16)(vv[0] & 0xffff); vd[72] = (u16)(vv[0] >> 16); vd[144] = (u16)(vv[1] & 0xffff); vd[216] = (u16)(vv[1] >> 16);
    vd[288] = (u16)(vv[2] & 0xffff); vd[360] = (u16)(vv[2] >> 16); vd[432] = (u16)(vv[3] & 0xffff); vd[504] = (u16)(vv[3] >> 16);
  }
  *(u32x4*)&Kl[(tid >> 2) * 104 + 64 + (tid & 3) * 8] = g.kr;
}
DI void attn_tile(const u16* Kl, const u16* Vt, const bf16x8 (&qf)[6], f32x16 (&O)[2], float& mrun, float& lrun, int r, int h) {
  const float sc = 0.14724455f;
  f32x16 st[2];
#pragma unroll
  for (int mt = 0; mt < 2; ++mt) {
    st[mt] = zero16();
#pragma unroll
    for (int s = 0; s < 6; ++s) st[mt] = MFMA32(*(const bf16x8*)&Kl[(32 * mt + r) * 104 + 16 * s + 8 * h], qf[s], st[mt]);
  }
  float mloc = -1e30f;
#pragma unroll
  for (int mt = 0; mt < 2; ++mt)
#pragma unroll
    for (int ii = 0; ii < 16; ++ii) { st[mt][ii] *= sc; mloc = fmaxf(mloc, st[mt][ii]); }
  mloc = fmaxf(mloc, __shfl_xor(mloc, 32));
  const float mnew = fmaxf(mrun, mloc);
  const float alpha = __builtin_amdgcn_exp2f(mrun - mnew);
  mrun = mnew;
  float ps = 0.f;
#pragma unroll
  for (int mt = 0; mt < 2; ++mt)
#pragma unroll
    for (int ii = 0; ii < 16; ++ii) { float p = __builtin_amdgcn_exp2f(st[mt][ii] - mnew); st[mt][ii] = p; ps += p; }
  lrun = lrun * alpha + ps;
#pragma unroll
  for (int ii = 0; ii < 16; ++ii) { O[0][ii] *= alpha; O[1][ii] *= alpha; }
#pragma unroll
  for (int mt = 0; mt < 2; ++mt)
#pragma unroll
    for (int s2 = 0; s2 < 2; ++s2) {
      bf16x8 pb = pack_frag(st[mt], s2);
#pragma unroll
      for (int dvt = 0; dvt < 2; ++dvt) {
        const u16* vp = &Vt[(32 * dvt + r) * 72 + 32 * mt + 16 * s2 + 4 * h];
        s16x4 lo = *(const s16x4*)vp;
        s16x4 hi = *(const s16x4*)(vp + 8);
        bf16x8 va = __builtin_shufflevector(lo, hi, 0, 1, 2, 3, 4, 5, 6, 7);
        O[dvt] = MFMA32(va, pb, O[dvt]);
      }
    }
}

DI void attn_item(const Params& P, const Grp& G, int it, char* ldsraw) {
  const int tid = otid(), lane = tid & 63, w = tid >> 6, r = lane & 31, h = lane >> 5;
  const int nqb = G.seqlen >> 7;
  const int qb = it % nqb, head = (it / nqb) & 7, sl = it / (nqb * 8);
  u16* Kl0 = (u16*)ldsraw;
  u16* Vt0 = Kl0 + 64 * 104;
  u16* Kl1 = Vt0 + 64 * 72;
  u16* Vt1 = Kl1 + 64 * 104;
  const size_t ltq = (size_t)sl * G.seqlen + qb * 128 + w * 32 + r;
  bf16x8 qf[6];
#pragma unroll
  for (int s = 0; s < 6; ++s) qf[s] = *(const bf16x8*)&pQ(P)[ltq * 768 + head * 96 + s * 16 + h * 8];
  const int nkt = G.kvlen >> 6;
  const size_t kvbase = (size_t)sl * G.kvlen;
  const u16* kvp = pKV(P);
  const u16* krp = pKR(P);
  float mrun = -1e30f, lrun = 0.f;
  f32x16 O[2];
  O[0] = zero16(); O[1] = zero16();
  KvRegs g0, g1;
  attn_gload(g0, kvp, krp, kvbase, tid, head);
  attn_gload(g1, kvp, krp, kvbase + 64, tid, head);
  __syncthreads();
  attn_lstore(g0, Kl0, Vt0, tid);
  __syncthreads();
  for (int kt = 0; kt < nkt; kt += 2) {
    if (kt + 2 < nkt) attn_gload(g0, kvp, krp, kvbase + (size_t)(kt + 2) * 64, tid, head);
    attn_tile(Kl0, Vt0, qf, O, mrun, lrun, r, h);
    attn_lstore(g1, Kl1, Vt1, tid);
    __syncthreads();
    if (kt + 3 < nkt) attn_gload(g1, kvp, krp, kvbase + (size_t)(kt + 3) * 64, tid, head);
    attn_tile(Kl1, Vt1, qf, O, mrun, lrun, r, h);
    if (kt + 2 < nkt) attn_lstore(g0, Kl0, Vt0, tid);
    __syncthreads();
  }
  const float ltot = lrun + __shfl_xor(lrun, 32);
  const float inv = 1.f / ltot;
#pragma unroll
  for (int dvt = 0; dvt < 2; ++dvt)
#pragma unroll
    for (int g4 = 0; g4 < 4; ++g4) {
      u16* gp = &pU(P)[ltq * UC + C_GA + head * 64 + 32 * dvt + 8 * g4 + 4 * h];
      uint2 gw = *(const uint2*)gp;
      float o0 = O[dvt][4 * g4] * inv * silu_f(bflo(gw.x));
      float o1 = O[dvt][4 * g4 + 1] * inv * silu_f(bfhi(gw.x));
      float o2 = O[dvt][4 * g4 + 2] * inv * silu_f(bflo(gw.y));
      float o3 = O[dvt][4 * g4 + 3] * inv * silu_f(bfhi(gw.y));
      *(uint2*)gp = make_uint2(pk2(o0, o1), pk2(o2, o3));
    }
}

DI void convb_item(const Params& P, const Grp& G, int l, int it) {
  const int tid = otid();
  const float* cw = P.conv_b_w + (size_t)l * 3 * 512;
  for (int rep = 0; rep < 16; ++rep) {
    int c = tid + 256 * rep;
    int row = c >> 6, c8 = (c & 63) * 8;
    size_t lt = (size_t)it * 64 + row;
    int tpos = (int)(lt % G.seqlen);
    float cc[8], xx[8], pm[8], p0[8], pp[8], bb[8], gg[8];
    unpack8(*(const uint4*)&pU(P)[lt * UC + C_C + c8], cc);
    unpack8(*(const uint4*)&pU(P)[lt * UC + C_X + c8], xx);
#pragma unroll
    for (int j = 0; j < 8; ++j) p0[j] = cc[j] * xx[j];
    if (tpos > 0) {
      unpack8(*(const uint4*)&pU(P)[(lt - 1) * UC + C_C + c8], cc);
      unpack8(*(const uint4*)&pU(P)[(lt - 1) * UC + C_X + c8], xx);
#pragma unroll
      for (int j = 0; j < 8; ++j) pm[j] = cc[j] * xx[j];
    } else { for (int j = 0; j < 8; ++j) pm[j] = 0.f; }
    if (tpos < G.seqlen - 1) {
      unpack8(*(const uint4*)&pU(P)[(lt + 1) * UC + C_C + c8], cc);
      unpack8(*(const uint4*)&pU(P)[(lt + 1) * UC + C_X + c8], xx);
#pragma unroll
      for (int j = 0; j < 8; ++j) pp[j] = cc[j] * xx[j];
    } else { for (int j = 0; j < 8; ++j) pp[j] = 0.f; }
    unpack8(*(const uint4*)&pU(P)[lt * UC + C_B + c8], bb);
    u16* gp = &pU(P)[lt * UC + C_GB + c8];
    unpack8(*(const uint4*)gp, gg);
    float o[8];
#pragma unroll
    for (int j = 0; j < 8; ++j)
      o[j] = bb[j] * (pm[j] * cw[c8 + j] + p0[j] * cw[512 + c8 + j] + pp[j] * cw[1024 + c8 + j]) * silu_f(gg[j]);
    *(uint4*)gp = pack8(o);
  }
}

DI void merge_tile(const Params& P, int it, char* ldsraw) {
  u16* lds = (u16*)ldsraw;
  const int mtile = (it & 7) * 8 + ((it >> 3) & 7), ntile = it >> 6;
  const int m0 = mtile * 128, n0 = ntile * 128;
  u16* Mb = pKV(P);
  unsigned mp[2][2][8];
#pragma unroll 1
  for (int br = 0; br < 3; ++br) {
    f32x16 acc[2][2];
    acc[0][0] = zero16(); acc[0][1] = zero16(); acc[1][0] = zero16(); acc[1][1] = zero16();
    gemm_mainloop(pH(P) + (size_t)m0 * 1024, 1024, pWT1(P) + (size_t)(C_MG + br * 1024 + n0) * 1024, 1024, 1024, lds, acc);
    unsigned sg[2][2][4];
#pragma unroll
    for (int a2 = 0; a2 < 2; ++a2)
#pragma unroll
      for (int b2 = 0; b2 < 2; ++b2)
#pragma unroll
        for (int i = 0; i < 4; ++i) {
          unsigned q0 = (unsigned)(sigmoid_f(acc[a2][b2][4 * i]) * 255.f + 0.5f), q1 = (unsigned)(sigmoid_f(acc[a2][b2][4 * i + 1]) * 255.f + 0.5f);
          unsigned q2 = (unsigned)(sigmoid_f(acc[a2][b2][4 * i + 2]) * 255.f + 0.5f), q3 = (unsigned)(sigmoid_f(acc[a2][b2][4 * i + 3]) * 255.f + 0.5f);
          sg[a2][b2][i] = q0 | (q1 << 8) | (q2 << 16) | (q3 << 24);
        }
    acc[0][0] = zero16(); acc[0][1] = zero16(); acc[1][0] = zero16(); acc[1][1] = zero16();
    const int ocol = (br == 0) ? C_GA : (br == 1 ? C_GB : C_Z);
    const u16* Wp = (br == 0) ? pWPA(P) : (br == 1 ? pWPB(P) : pWPC(P));
    gemm_mainloop1(pU(P) + (size_t)m0 * UC + ocol, UC, Wp + (size_t)n0 * 512, 512, 512, lds, acc);
#pragma unroll
    for (int a2 = 0; a2 < 2; ++a2)
#pragma unroll
      for (int b2 = 0; b2 < 2; ++b2)
#pragma unroll
        for (int i = 0; i < 4; ++i) {
          const unsigned wq = sg[a2][b2][i];
          acc[a2][b2][4 * i] *= (float)(wq & 255u) * (1.f / 255.f);
          acc[a2][b2][4 * i + 1] *= (float)((wq >> 8) & 255u) * (1.f / 255.f);
          acc[a2][b2][4 * i + 2] *= (float)((wq >> 16) & 255u) * (1.f / 255.f);
          acc[a2][b2][4 * i + 3] *= (float)(wq >> 24) * (1.f / 255.f);
        }
    if (br < 2) {
#pragma unroll
      for (int a2 = 0; a2 < 2; ++a2)
#pragma unroll
        for (int b2 = 0; b2 < 2; ++b2)
#pragma unroll
          for (int i = 0; i < 8; ++i) {
            float lo = acc[a2][b2][2 * i], hi = acc[a2][b2][2 * i + 1];
            if (br > 0) { lo += bflo(mp[a2][b2][i]); hi += bfhi(mp[a2][b2][i]); }
            mp[a2][b2][i] = pk2(lo, hi);
          }
    } else {
#pragma unroll
      for (int a2 = 0; a2 < 2; ++a2)
#pragma unroll
        for (int b2 = 0; b2 < 2; ++b2)
#pragma unroll
          for (int i = 0; i < 8; ++i) { acc[a2][b2][2 * i] += bflo(mp[a2][b2][i]); acc[a2][b2][2 * i + 1] += bfhi(mp[a2][b2][i]); }
      gemm_epilogue(acc, (float*)ldsraw, [&](int row, int col, float* v) {
        *(uint4*)&Mb[(size_t)(m0 + row) * 1024 + n0 + col] = pack8(v);
      });
    }
  }
}

DI void out_tile(const Params& P, const Grp& G, int l, int it, char* ldsraw) {
  u16* lds = (u16*)ldsraw;
  const int mtile = (it & 7) * 8 + ((it >> 3) & 7), ntile = it >> 6;
  const int m0 = mtile * 128, n0 = ntile * 128;
  f32x16 acc[2][2];
  acc[0][0] = zero16(); acc[0][1] = zero16(); acc[1][0] = zero16(); acc[1][1] = zero16();
  gemm_mainloop(pKV(P) + (size_t)m0 * 1024, 1024, pWO(P) + (size_t)n0 * 1024, 1024, 1024, lds, acc);
  gemm_epilogue<4>(acc, (float*)ldsraw, [&](int row, int col, float* v) {
    int lt = m0 + row, n = n0 + col;
    int tok = G.tok0 + lt;
    int cond = G.latent ? 1 + G.seq0 + (lt >> 11) : 0;
    const float* gate = pMOD(P) + (l * 9 + cond) * 3072 + 2048 + n;
    const float* xr = x_row(P, l, tok) + n;
    float4 x0 = *(const float4*)xr, x1 = *(const float4*)(xr + 4);
    float4 g0 = *(const float4*)(gate + 4 * 55296), g1 = *(const float4*)(gate + 4 * 55296 + 4);
    float* dst = P.out + (size_t)tok * 1024 + n;
    *(float4*)dst = make_float4(x0.x + g0.x * v[0], x0.y + g0.y * v[1], x0.z + g0.z * v[2], x0.w + g0.w * v[3]);
    *(float4*)(dst + 4) = make_float4(x1.x + g1.x * v[4], x1.y + g1.y * v[5], x1.z + g1.z * v[6], x1.w + g1.w * v[7]);
  });
}

DI void final_norm_phase(const Params& P) {
  int wave = (blockIdx.x * 256 + otid()) >> 6, lane = otid() & 63, nw = gridDim.x * 4;
  for (int r = wave; r < 24576; r += nw) {
    float* xr = P.out + (size_t)r * 1024;
    float4 v[4];
    float ss = 0.f;
#pragma unroll
    for (int i = 0; i < 4; ++i) {
      v[i] = *(const float4*)(xr + i * 256 + lane * 4);
      ss += v[i].x * v[i].x + v[i].y * v[i].y + v[i].z * v[i].z + v[i].w * v[i].w;
    }
    ss = wave_sum(ss);
    float rstd = rsqrtf(ss * (1.f / 1024.f) + 1e-6f);
#pragma unroll
    for (int i = 0; i < 4; ++i) {
      int col = i * 256 + lane * 4;
      float4 gg = *(const float4*)(P.final_norm_g + col);
      *(float4*)(xr + col) = make_float4(v[i].x * rstd * gg.x, v[i].y * rstd * gg.y, v[i].z * rstd * gg.z, v[i].w * rstd * gg.w);
    }
  }
}

#define XB_TMO      128
#define XB_XCNT(j)  (256  + 64 * (j))
#define XB_XSUB(j)  (1280 + 64 * (j))
#define XB_XGEN(j)  (2304 + 64 * (j))
#define XB_TOP      3328
#define XB_TOPGEN   3392
#define XCD_BAR_WORDS 3456
#define XB_SPIN_CAP (1u << 18)
#define LAS __attribute__((address_space(3)))

__device__ __forceinline__ unsigned xb_ld(unsigned* p)              { return __hip_atomic_load(p, __ATOMIC_RELAXED, __HIP_MEMORY_SCOPE_AGENT); }
__device__ __forceinline__ unsigned xb_add(unsigned* p, unsigned v) { return __hip_atomic_fetch_add(p, v, __ATOMIC_RELAXED, __HIP_MEMORY_SCOPE_AGENT); }
__device__ __forceinline__ unsigned xb_xcc_id() { return (unsigned)__builtin_amdgcn_s_getreg((3 << 11) | 20) & 0xFu; }
#define XB_SPIN(cond, bar) do { unsigned _sp = 0; while (cond) { __builtin_amdgcn_s_sleep(1); \
    if ((++_sp & 255u) == 0u) { if (xb_ld(&(bar)[XB_TMO])) break; if (_sp > XB_SPIN_CAP) { atomicAdd(&(bar)[XB_TMO], 1u); break; } } } } while (0)

struct XcdBarrier {
    unsigned* bar; unsigned x;
    volatile LAS unsigned* st;
};

__device__ __forceinline__ XcdBarrier xcd_barrier_post(unsigned* bar, volatile LAS unsigned* st) {
    XcdBarrier b; b.bar = bar; b.x = xb_xcc_id(); b.st = st;
    if (threadIdx.x == 0) (void)xb_add(&bar[XB_XCNT(b.x)], 1u);
    return b;
}
__device__ __forceinline__ void xcd_barrier_complete(unsigned* bar, unsigned x, unsigned& nloc, unsigned& nx) {
    const unsigned G = gridDim.x * gridDim.y * gridDim.z;
    unsigned sum, cnt, mine, sp = 0u;
    for (;;) {
        sum = 0u; cnt = 0u; mine = 0u;
#pragma unroll
        for (unsigned j = 0; j < 16; ++j) { const unsigned c = xb_ld(&bar[XB_XCNT(j)]); sum += c; cnt += (c > 0u) ? 1u : 0u; mine = (j == x) ? c : mine; }
        if (sum == G) break;
        __builtin_amdgcn_s_sleep(1);
        if ((++sp & 255u) == 0u) { if (xb_ld(&bar[XB_TMO])) break; if (sp > XB_SPIN_CAP) { atomicAdd(&bar[XB_TMO], 1u); break; } }
    }
    nloc = mine > 0u ? mine : 1u; nx = cnt > 0u ? cnt : 1u;
}

__device__ __forceinline__ void xcd_barrier(const XcdBarrier& b) {
    asm volatile("s_waitcnt vmcnt(0)" ::: "memory");
    __syncthreads();
    if (threadIdx.x == 0) {
        unsigned* bar = b.bar;
        __builtin_amdgcn_s_waitcnt(0);
        unsigned nloc = b.st[0], nx = b.st[1];
        if (nloc == 0u) { xcd_barrier_complete(bar, b.x, nloc, nx); b.st[0] = nloc; b.st[1] = nx; }
        const unsigned old = xb_add(&bar[XB_XSUB(b.x)], 1u);
        const unsigned gen = old / nloc;
        if (old + 1u == (gen + 1u) * nloc) {
            __builtin_amdgcn_fence(__ATOMIC_RELEASE, "agent");
            asm volatile("s_waitcnt vmcnt(0)" ::: "memory");
            const unsigned og = xb_add(&bar[XB_TOP], 1u);
            const unsigned tg = og / nx;
            if (og + 1u == (tg + 1u) * nx) xb_add(&bar[XB_TOPGEN], 1u);
            else XB_SPIN(xb_ld(&bar[XB_TOPGEN]) == tg, bar);
            __builtin_amdgcn_fence(__ATOMIC_ACQUIRE, "agent");
            xb_add(&bar[XB_XGEN(b.x)], 1u);
            asm volatile("s_waitcnt vmcnt(0)" ::: "memory");
        } else {
            XB_SPIN(xb_ld(&bar[XB_XGEN(b.x)]) == gen, bar);
            __builtin_amdgcn_fence(__ATOMIC_ACQUIRE, "agent");
            asm volatile("s_waitcnt vmcnt(0)" ::: "memory");
        }
    }
    __syncthreads();
}

#ifndef PROBE
#define PROBE 0
#endif
#define GSYNC() do { xcd_barrier(xb); if (PROBE & 1) xcd_barrier(xb); } while (0)
__global__ void __launch_bounds__(256, 2) mega(Params P) {
  cg::grid_group grid = cg::this_grid();
  __shared__ __attribute__((aligned(16))) char lds[LDS_TOTAL];
  __shared__ __attribute__((aligned(16))) unsigned xb_words[4];
  __shared__ int s_item;
  if (threadIdx.x < 4) xb_words[threadIdx.x] = 0u;
  __syncthreads();
  const XcdBarrier xb = xcd_barrier_post((unsigned*)(P.ws + O_BAR), (volatile LAS unsigned*)xb_words);
  if (P.out == nullptr) grid.sync();
  for (int it = blockIdx.x; it < 384; it += gridDim.x) mod_item(P, it, (float*)lds);
  convert_phase(P, 0, (float*)lds);
  GSYNC();
  norm_phase(P, make_grp(0), 0, true);
  GSYNC();
  for (int l = 0; l < 2; ++l) {
    if (l == 1) { convert_phase(P, 1, (float*)lds); norm_phase(P, make_grp(0), 1); GSYNC(); }
    for (int g = 0; g < 3; ++g) {
      const Grp G = make_grp(g);
      if (l == 0 && g == 0) {
        float* md = pMOD(P);
        for (int i = blockIdx.x * 256 + threadIdx.x; i < 55296; i += gridDim.x * 256)
          md[4 * 55296 + i] = md[i] + md[55296 + i] + md[2 * 55296 + i] + md[3 * 55296 + i];
      }
      for (int rep = 0; rep < ((PROBE & 2) ? 2 : 1); ++rep) gemm1_phase(P, G, l, lds);
      GSYNC();
      for (int rep = 0; rep < ((PROBE & 4) ? 2 : 1); ++rep) {
        const int nq = 64 * 6, nkv = (G.latent ? 72 : 64) * 8, ngd = 128 * 8, nx = 128;
        for (int it = blockIdx.x; it < nq + nkv + ngd + nx; it += gridDim.x) {
          if (it < ngd) gdn_prep_item(P, G, l, it, lds);
          else if (it < ngd + nx) { const int e = it - ngd; gemm1_tile(P, G, l, e >> 1, 6 + (e & 1), lds); }
          else if (it < ngd + nx + nkv) kvexp_tile(P, G, l, it - ngd - nx, lds);
          else qproj_tile(P, G, it - ngd - nx - nkv, lds);
        }
      }
      GSYNC();
      {
        const int nsc = G.nseq * 8, nat = 512, ncv = 128;
        unsigned* ctr = (unsigned*)(P.ws + O_BAR) + (l * 3 + g);
        const int total = nsc + nat + ncv;
        auto run_item = [&](int it) {
          if (it < nsc) gdn_scan_item(P, G, l, it);
          else if (it < nsc + nat) attn_item(P, G, it - nsc, lds);
          else convb_item(P, G, l, it - nsc - nat);
        };
        const int heavy = (G.latent && gridDim.x == 512) ? nsc : 0;
        for (int k = 0, it = blockIdx.x; it < total; ++k) {
          run_item(it);
          it = (k == 0) ? (int)gridDim.x + (int)((blockIdx.x + gridDim.x - heavy) % gridDim.x) : it + (int)gridDim.x;
        }
      }
      GSYNC();
      stagger();
      for (int rep = 0; rep < ((PROBE & 8) ? 2 : 1); ++rep)
        for (int it = blockIdx.x; it < 512; it += gridDim.x) merge_tile(P, it, lds);
      GSYNC();
      for (int it = blockIdx.x; it < 512; it += gridDim.x) out_tile(P, G, l, it, lds);
      if (g < 2) norm_phase(P, make_grp(g + 1), l);
      GSYNC();
    }
  }
  final_norm_phase(P);
}

extern "C" void kernel_launch(void* const* d_in, const int* in_sizes, int n_in, void* d_out, int out_size,
                              void* d_ws, size_t ws_size, hipStream_t stream) {
  static int grid_blocks = 0;
  if (!grid_blocks) {
    int dev = 0, cus = 0, per_cu = 0;
    hipGetDevice(&dev);
    hipDeviceGetAttribute(&cus, hipDeviceAttributeMultiprocessorCount, dev);
    hipOccupancyMaxActiveBlocksPerMultiprocessor(&per_cu, mega, 256, 0);
    if (per_cu > 2) per_cu = 2;
    if (per_cu < 1) per_cu = 1;
    grid_blocks = cus * per_cu;
  }
  Params p{};
  const float** pin = (const float**)&p;
  for (int i = 0; i < 25; ++i) pin[i] = (const float*)d_in[i];
  p.out = (float*)d_out;
  p.ws = (char*)d_ws;
  if (WS_NEED > ws_size) { fprintf(stderr, "workspace too small: need %zu have %zu\n", (size_t)WS_NEED, ws_size); return; }
  (void)hipMemsetAsync((char*)d_ws + O_BAR, 0, 16384, stream);
  void* args[] = {&p};
  hipError_t e = hipLaunchCooperativeKernel((void*)mega, dim3(grid_blocks), dim3(256), args, 0, stream);
  if (e != hipSuccess) fprintf(stderr, "cooperative launch failed: %s (grid %d)\n", hipGetErrorString(e), grid_blocks);
}
```
